# Optimizing an MI355X kernel written in HIP

```python
import math
import jax, jax.numpy as jnp
from jax import lax
import numpy as np

D_MODEL = 1024
BATCH = 8
SEQ = 2048
DEPTH = 1
DEC_BATCH = 32
DEC_SEQ = 4
PAST_LEN = 16384
PAGE_SIZE = 128

HEAD_DIM = 64
N_HEADS_A = 8
N_KV_A = 2
N_IDX_HEADS = 8
D_IDX = 64
TOPK_MAX = 256
N_HEADS_B = 8
D_A = N_HEADS_A * HEAD_DIM
D_B = N_HEADS_B * HEAD_DIM
D_MIX = D_A + D_B
D_PLE = 256
N_BUCKETS = 32
MAX_DISTANCE = 128
ROPE_BASE = 10000.0
RET_CHUNK = 128
Q_BLOCK = 128
EPS = 1e-6
SPLIT_SIZES = (D_A, N_KV_A * HEAD_DIM, N_KV_A * HEAD_DIM, N_IDX_HEADS * D_IDX, D_IDX, N_IDX_HEADS, D_A, D_B, D_B, D_B, D_B)
D_IN = D_A + 2 * N_KV_A * HEAD_DIM + N_IDX_HEADS * D_IDX + D_IDX + N_IDX_HEADS + D_A + 4 * D_B

kernel_name = 'hymba_dsa_retention_step'


def _rmsnorm(x, g):
    xf = x.astype(jnp.float32)
    y = xf * lax.rsqrt(jnp.mean(xf * xf, axis=-1, keepdims=True) + EPS) * g.astype(jnp.float32)
    return y.astype(x.dtype)


def _head_norm(o):
    mu = jnp.mean(o, axis=-1, keepdims=True)
    var = jnp.mean(jnp.square(o - mu), axis=-1, keepdims=True)
    return (o - mu) * lax.rsqrt(var + EPS)


def _rope(x, pos):
    half = x.shape[-1] // 2
    inv = ROPE_BASE ** (-jnp.arange(half, dtype=jnp.float32) / half)
    ang = pos.astype(jnp.float32)[:, None] * inv[None, :]
    cos = jnp.cos(ang)[:, None, :]
    sin = jnp.sin(ang)[:, None, :]
    xf = x.astype(jnp.float32)
    x1, x2 = xf[..., :half], xf[..., half:]
    return jnp.concatenate([x1 * cos - x2 * sin, x1 * sin + x2 * cos], axis=-1).astype(x.dtype)


def _t5_bucket(n):
    max_exact = N_BUCKETS // 2
    n = jnp.maximum(n, 0)
    nf = jnp.maximum(n, 1).astype(jnp.float32)
    large = max_exact + (jnp.log(nf / max_exact) / math.log(MAX_DISTANCE / max_exact)
                         * (N_BUCKETS - max_exact)).astype(jnp.int32)
    large = jnp.minimum(large, N_BUCKETS - 1)
    return jnp.where(n < max_exact, n, large)


def _project(h, w_in, pos):
    B, T, _ = h.shape
    z = jnp.einsum('btd,de->bte', h, w_in)
    offsets = np.cumsum(SPLIT_SIZES)[:-1].tolist()
    qa, ka, va, qi, ki, wi, ga, qb, kb, vb, gb = jnp.split(z, offsets, axis=-1)
    qa = qa.reshape(B, T, N_HEADS_A, HEAD_DIM)
    ka = ka.reshape(B, T, N_KV_A, HEAD_DIM)
    va = va.reshape(B, T, N_KV_A, HEAD_DIM)
    qi = qi.reshape(B, T, N_IDX_HEADS, D_IDX)
    wi = wi * (N_IDX_HEADS ** -0.5)
    qb = _rope(qb.reshape(B, T, N_HEADS_B, HEAD_DIM), pos)
    kb = _rope(kb.reshape(B, T, N_HEADS_B, HEAD_DIM), pos) * (HEAD_DIM ** -0.5)
    vb = vb.reshape(B, T, N_HEADS_B, HEAD_DIM)
    return qa, ka, va, qi, ki, wi, ga, qb, kb, vb, gb


def _index_select(qi, wi, ki, qpos, kpos, topk):
    s = jnp.einsum('bqhd,bsd->bqhs', qi.astype(jnp.float32), ki.astype(jnp.float32)) * (D_IDX ** -0.5)
    score = jnp.einsum('bqh,bqhs->bqs', wi.astype(jnp.float32), jax.nn.relu(s))
    valid = kpos[None, None, :] <= qpos[None, :, None]
    score = jnp.where(valid, score, -jnp.inf)
    top_val, top_idx = lax.top_k(score, topk)
    return top_idx, jnp.isfinite(top_val)


def _sparse_attend(q, kg, vg, qpos, sel_pos, sel_ok, rel_bias):
    B, Q = q.shape[:2]
    K = sel_pos.shape[-1]
    G = N_HEADS_A // N_KV_A
    qg = q.reshape(B, Q, N_KV_A, G, HEAD_DIM).astype(jnp.float32)
    logits = jnp.einsum('bqngd,bqknd->bqngk', qg, kg.astype(jnp.float32)) * (HEAD_DIM ** -0.5)
    bucket = _t5_bucket(qpos[None, :, None] - sel_pos)
    bias = rel_bias.astype(jnp.float32)[bucket]
    bias = bias.reshape(B, Q, K, N_KV_A, G).transpose(0, 1, 3, 4, 2)
    logits = jnp.where(sel_ok[:, :, None, None, :], logits + bias, -jnp.inf)
    probs = jax.nn.softmax(logits, axis=-1)
    o = jnp.einsum('bqngk,bqknd->bqngd', probs, vg.astype(jnp.float32))
    return o.reshape(B, Q, N_HEADS_A, HEAD_DIM)


def _gather_rows(a, idx):
    return jax.vmap(lambda ab, ib: ab[ib])(a, idx)


def _dsa_prompt(qa, ka, va, qi, ki, wi, rel_bias):
    B, T = qa.shape[:2]
    topk = min(TOPK_MAX, T // 4)
    blk = math.gcd(T, Q_BLOCK)
    kpos = jnp.arange(T)

    def one_block(t0):
        sl = lambda a: lax.dynamic_slice_in_dim(a, t0, blk, axis=1)
        qpos = t0 + jnp.arange(blk)
        idx, ok = _index_select(sl(qi), sl(wi), ki, qpos, kpos, topk)
        kg = _gather_rows(ka, idx)
        vg = _gather_rows(va, idx)
        return _sparse_attend(sl(qa), kg, vg, qpos, idx, ok, rel_bias)

    out = lax.map(one_block, jnp.arange(T // blk) * blk)
    return out.transpose(1, 0, 2, 3, 4).reshape(B, T, N_HEADS_A, HEAD_DIM)


def _dsa_sample(qa, ka, va, qi, ki, wi, cache_k, cache_v, cache_kidx, page_table, rel_bias):
    B, T = qa.shape[:2]
    n_pages = page_table.shape[1]
    past = n_pages * PAGE_SIZE
    L = past + T
    topk = min(TOPK_MAX, L // 4)
    ki_past = cache_kidx[page_table].reshape(B, past, D_IDX).astype(ki.dtype)
    ki_all = jnp.concatenate([ki_past, ki], axis=1)
    qpos = past + jnp.arange(T)
    kpos = jnp.arange(L)
    idx, ok = _index_select(qi, wi, ki_all, qpos, kpos, topk)
    is_past = idx < past
    pidx = jnp.minimum(idx, past - 1)
    phys_page = jnp.take_along_axis(page_table, (pidx // PAGE_SIZE).reshape(B, -1), axis=1).reshape(idx.shape)
    phys_row = phys_page * PAGE_SIZE + pidx % PAGE_SIZE
    nidx = jnp.clip(idx - past, 0, T - 1)
    flat_k = cache_k.reshape(-1, N_KV_A, HEAD_DIM)
    flat_v = cache_v.reshape(-1, N_KV_A, HEAD_DIM)
    kg = jnp.where(is_past[..., None, None], flat_k[phys_row].astype(ka.dtype), _gather_rows(ka, nidx))
    vg = jnp.where(is_past[..., None, None], flat_v[phys_row].astype(va.dtype), _gather_rows(va, nidx))
    return _sparse_attend(qa, kg, vg, qpos, idx, ok, rel_bias)


def _retention(q, k, v, state0):
    B, T, H, dk = q.shape
    dv = v.shape[-1]
    C = math.gcd(T, RET_CHUNK)
    n = T // C
    log_g = jnp.log1p(-jnp.exp2(-5.0 - jnp.arange(H, dtype=jnp.float32)))
    i = jnp.arange(C, dtype=jnp.float32)
    diff = i[:, None] - i[None, :]
    dmat = jnp.where(diff >= 0, jnp.exp(jnp.maximum(diff, 0.0)[None] * log_g[:, None, None]), 0.0)
    dec_in = jnp.exp((i + 1.0)[:, None] * log_g[None, :])
    dec_out = jnp.exp((C - 1.0 - i)[:, None] * log_g[None, :])
    dec_chunk = jnp.exp(C * log_g)

    def to_chunks(a):
        return a.astype(jnp.float32).reshape(B, n, C, H, a.shape[-1]).transpose(1, 0, 2, 3, 4)

    def step(S, inp):
        qc, kc, vc = inp
        inter = jnp.einsum('bchk,bhkv->bchv', qc * dec_in[None, :, :, None], S)
        scores = jnp.einsum('bchk,bshk->bhcs', qc, kc) * dmat[None]
        intra = jnp.einsum('bhcs,bshv->bchv', scores, vc)
        S = S * dec_chunk[None, :, None, None] + jnp.einsum('bchk,bchv->bhkv', kc * dec_out[None, :, :, None], vc)
        return S, inter + intra

    S, ys = lax.scan(step, state0.astype(jnp.float32), (to_chunks(q), to_chunks(k), to_chunks(v)))
    o = ys.transpose(1, 0, 2, 3, 4).reshape(B, T, H, dv)
    return o, S


def _merge(x, oa, ob, ga, gb, p, w_out, g_post, w_ple_up, w_ple_gate):
    B, T, _ = x.shape
    ya = jax.nn.silu(ga) * oa.reshape(B, T, D_A).astype(x.dtype)
    yb = jax.nn.silu(gb) * _head_norm(ob).reshape(B, T, D_B).astype(x.dtype)
    y = jnp.einsum('bte,ed->btd', jnp.concatenate([ya, yb], axis=-1), w_out)
    x = x + _rmsnorm(y, g_post)
    ple = jnp.einsum('btp,pd->btd', p.astype(x.dtype), w_ple_up)
    gate = jax.nn.sigmoid(jnp.einsum('btd,de->bte', x, w_ple_gate))
    return x + ple * gate


def setup_inputs(seed: int = 0) -> dict:
    key = jax.random.key(seed)
    ks = jax.random.split(key, 20)
    f32 = jnp.float32
    n_pages = PAST_LEN // PAGE_SIZE
    n_used = DEC_BATCH * n_pages
    n_pool = n_used + max(1, n_used // 4)
    perm = jax.random.permutation(ks[0], n_pool)[:n_used]
    page_table = perm.reshape(DEC_BATCH, n_pages).astype(jnp.int32)
    nrm = lambda k, shape, s: jax.random.normal(k, shape, f32) * s
    return {
        'x_prompt': nrm(ks[1], (BATCH, SEQ, D_MODEL), 1.0),
        'x_sample': nrm(ks[2], (DEC_BATCH, DEC_SEQ, D_MODEL), 1.0),
        'cache_k': nrm(ks[3], (DEPTH, n_pool, PAGE_SIZE, N_KV_A, HEAD_DIM), 1.0),
        'cache_v': nrm(ks[4], (DEPTH, n_pool, PAGE_SIZE, N_KV_A, HEAD_DIM), 1.0),
        'cache_kidx': nrm(ks[5], (DEPTH, n_pool, PAGE_SIZE, D_IDX), 1.0),
        'state_ret': nrm(ks[6], (DEPTH, DEC_BATCH, N_HEADS_B, HEAD_DIM, HEAD_DIM), 0.5),
        'page_table': page_table,
        'p_prompt': nrm(ks[7], (DEPTH, BATCH, SEQ, D_PLE), 1.0),
        'p_sample': nrm(ks[8], (DEPTH, DEC_BATCH, DEC_SEQ, D_PLE), 1.0),
        'rel_bias': nrm(ks[9], (N_BUCKETS, N_HEADS_A), 0.1),
        'w_in': nrm(ks[10], (DEPTH, D_MODEL, D_IN), D_MODEL ** -0.5),
        'w_out': nrm(ks[11], (DEPTH, D_MIX, D_MODEL), D_MIX ** -0.5),
        'g_pre': 1.0 + nrm(ks[12], (DEPTH, D_MODEL), 0.01),
        'g_post': 1.0 + nrm(ks[13], (DEPTH, D_MODEL), 0.01),
        'w_ple_up': nrm(ks[14], (DEPTH, D_PLE, D_MODEL), D_PLE ** -0.5),
        'w_ple_gate': nrm(ks[15], (DEPTH, D_MODEL, D_MODEL), D_MODEL ** -0.5),
    }


def reference(x_prompt, x_sample, cache_k, cache_v, cache_kidx, state_ret, page_table, p_prompt, p_sample,
              rel_bias, w_in, w_out, g_pre, g_post, w_ple_up, w_ple_gate):
    B, T = x_prompt.shape[:2]
    Ts = x_sample.shape[1]
    pos_p = jnp.arange(T)
    pos_s = PAST_LEN + jnp.arange(Ts)
    xp, xs = x_prompt, x_sample
    kp_l, vp_l, ip_l, sp_l = [], [], [], []
    ks_l, vs_l, is_l, ss_l = [], [], [], []
    for i in range(DEPTH):
        hp = _rmsnorm(xp, g_pre[i])
        qa, ka, va, qi, ki, wi, ga, qb, kb, vb, gb = _project(hp, w_in[i], pos_p)
        oa = _dsa_prompt(qa, ka, va, qi, ki, wi, rel_bias)
        ob, sp = _retention(qb, kb, vb, jnp.zeros((B, N_HEADS_B, HEAD_DIM, HEAD_DIM), jnp.float32))
        xp = _merge(xp, oa, ob, ga, gb, p_prompt[i], w_out[i], g_post[i], w_ple_up[i], w_ple_gate[i])
        kp_l.append(ka)
        vp_l.append(va)
        ip_l.append(ki)
        sp_l.append(sp.astype(state_ret.dtype))
        hs = _rmsnorm(xs, g_pre[i])
        qa, ka, va, qi, ki, wi, ga, qb, kb, vb, gb = _project(hs, w_in[i], pos_s)
        oa = _dsa_sample(qa, ka, va, qi, ki, wi, cache_k[i], cache_v[i], cache_kidx[i], page_table, rel_bias)
        ob, ss = _retention(qb, kb, vb, state_ret[i])
        xs = _merge(xs, oa, ob, ga, gb, p_sample[i], w_out[i], g_post[i], w_ple_up[i], w_ple_gate[i])
        ks_l.append(ka)
        vs_l.append(va)
        is_l.append(ki)
        ss_l.append(ss.astype(state_ret.dtype))
    k_prompt = jnp.stack(kp_l)
    v_prompt = jnp.stack(vp_l)
    kidx_prompt = jnp.stack(ip_l)
    ret_state_prompt = jnp.stack(sp_l)
    k_sample = jnp.stack(ks_l)
    v_sample = jnp.stack(vs_l)
    kidx_sample = jnp.stack(is_l)
    ret_state_sample = jnp.stack(ss_l)
    return (xp, xs, k_prompt, v_prompt, kidx_prompt, ret_state_prompt, k_sample, v_sample, kidx_sample, ret_state_sample)
```

```cpp
#include <hip/hip_runtime.h>
#include <cstdio>
#include <cstdint>

constexpr int NWAVES = 8;
constexpr int DM = 1024, NB = 8, T = 2048, M = NB * T, SB = 32, SQ = 4, MS = SB * SQ, PAST = 16384, PAGE = 128, NPG = PAST / PAGE;
constexpr int D_IN = 3912, NPAD = 4096, DPLE = 256;
constexpr int C_QA = 0, C_KA = 512, C_VA = 640, C_QI = 768, C_KI = 1280, C_WI = 1344, C_GA = 1352, C_QB = 1864, C_KB = 2376, C_VB = 2888, C_GB = 3400;
constexpr float EPS = 1e-6f;
constexpr float LOG2E = 1.4426950408889634f;
constexpr float WSCALE = 0.04419417382415922f;
constexpr size_t O_YP = 0, O_YS = 16777216, O_KP = 16908288, O_VP = 19005440, O_KIP = 21102592, O_RSP = 22151168, O_KS = 22413312, O_VS = 22429696, O_KIS = 22446080, O_RSS = 22454272, O_END = 23502848;
constexpr size_t MiB = 1u << 20;
constexpr size_t WS_CTL = 0, CTL_ZERO_BYTES = 1 * MiB;
constexpr size_t WS_WIN = 2 * MiB, WS_WOUT = 10 * MiB, WS_WGATE = 12 * MiB, WS_WUP = 14 * MiB;
constexpr size_t WS_RSTD = 15 * MiB, WS_ROPE = 15 * MiB + 256 * 1024, WS_BIAS = 15 * MiB + 832 * 1024, WS_XCH = 16 * MiB, WS_ZS = 17 * MiB, WS_SCS = 20 * MiB, WS_YS = 28 * MiB, WS_YMS = 29 * MiB;
constexpr size_t WS_XB = 32 * MiB, WS_PB = 64 * MiB, WS_QA = 72 * MiB, WS_KA = 88 * MiB, WS_VA = 92 * MiB, WS_QI = 96 * MiB, WS_KI = 112 * MiB, WS_WI = 114 * MiB;
constexpr size_t WS_GA = 116 * MiB, WS_QB = 132 * MiB, WS_KB = 148 * MiB, WS_VB = 164 * MiB, WS_GB = 180 * MiB, WS_PLE = 196 * MiB, WS_YM = 228 * MiB, WS_X1B = 260 * MiB, WS_END = 292 * MiB;
static_assert(WS_ROPE + (size_t)2052 * 32 * 2 * 4 <= WS_BIAS && WS_BIAS + 128 * 8 * 4 <= WS_XCH && WS_ZS + (size_t)MS * D_IN * 4 <= WS_SCS, "ws map");
constexpr int CW_TMO = 0, CW_BAR = 4096, CW_SEAM = 16384, CW_QUEUE = 24576, CW_SSQ = 32768;
constexpr int RING_BYTES = 131072, AUX_OFF = RING_BYTES, AUX_BYTES = 15360, LDSCTL_OFF = AUX_OFF + AUX_BYTES, LDS_BYTES = 147456;
static_assert(LDSCTL_OFF + 256 <= LDS_BYTES, "LDS map");

namespace pg8 {
#define PG8_LAS __attribute__((address_space(3)))
typedef unsigned short bf16_t;
typedef short bf16x8 __attribute__((ext_vector_type(8)));
typedef float f32x4 __attribute__((ext_vector_type(4)));
typedef unsigned u32x4 __attribute__((ext_vector_type(4)));
constexpr int BM = 256, BK = 64, HALF = 128, HTB = HALF * BK * 2  , STAGE_BYTES = 8 * HTB, NXCD = 8, WGM = 8;

__host__ __device__ __forceinline__ int lds_byte(int r, int c) { const int st = (r >> 4) * 2 + (c >> 5), rr = r & 15, cc = c & 31, ob = rr * 64 + cc * 2; return st * 1024 + (ob ^ (((ob >> 9) & 1) << 5)); }
__host__ __device__ __forceinline__ void stage_rc(int b, int& R, int& C) { const int st = b / 1024, sb = b % 1024, swz = sb ^ (((sb >> 9) & 1) << 5); R = (st >> 1) * 16 + swz / 64; C = (st & 1) * 32 + (swz % 64) / 2; }
__host__ __device__ __forceinline__ int perm32(int rho) { const int n = rho >> 4, i = rho & 15; return 8 * (i >> 2) + 4 * n + (i & 3); }

struct Unit { int pm, pn; };
struct Gemm { const bf16_t* A; const bf16_t* Bt; int M, N, K; };

struct StaticOrder {
    int nM, nN, nwg, G, c;
    __host__ __device__ void init(int M, int N, int G_, int c_) { nM = M / BM; nN = N / BM; nwg = nM * nN; G = G_; c = c_; }
    __host__ __device__ bool next(int i, Unit& u) const {
        const long L = (long)i * G + c; if (L >= nwg) return false;
        int wgid = (int)L; { const int q = nwg / NXCD, r = nwg % NXCD, xcd = wgid % NXCD, off = wgid / NXCD; wgid = (xcd < r ? xcd * (q + 1) : r * (q + 1) + (xcd - r) * q) + off; }
        const int nig = WGM * nN, gid = wgid / nig, fm = gid * WGM, gsz = (nM - fm) < WGM ? (nM - fm) : WGM;
        u.pm = fm + ((wgid % nig) % gsz); u.pn = (wgid % nig) / gsz; return true;
    }
    __device__ __forceinline__ void a_ready(const Unit&) const {}
    __device__ __forceinline__ void done(const Unit&) const {}
};


typedef float f32x2 __attribute__((ext_vector_type(2)));
typedef __bf16 bf16x2_n __attribute__((ext_vector_type(2)));
typedef unsigned u32x2 __attribute__((ext_vector_type(2)));
__device__ __forceinline__ unsigned cvt_pk_bf16(float lo, float hi) { unsigned r; asm volatile("v_cvt_pk_bf16_f32 %0, %1, %2" : "=v"(r) : "v"(lo), "v"(hi)); return r; }
__device__ __forceinline__ unsigned cvt_pk_bf16_c(float lo, float hi) { f32x2 v = {lo, hi}; bf16x2_n b = __builtin_convertvector(v, bf16x2_n); return __builtin_bit_cast(unsigned, b); }
__device__ __forceinline__ void store8_bf16(bf16_t* p, f32x4 v0, f32x4 v1) { u32x4 w; w.x = cvt_pk_bf16(v0[0], v0[1]); w.y = cvt_pk_bf16(v0[2], v0[3]); w.z = cvt_pk_bf16(v1[0], v1[1]); w.w = cvt_pk_bf16(v1[2], v1[3]); *(u32x4*)p = w; }
__device__ __forceinline__ float silu_f(float x) { return x * __builtin_amdgcn_rcpf(1.0f + __builtin_amdgcn_exp2f(-1.4426950408889634f * x)); }
__device__ __forceinline__ float sigmoid_f(float x) { return __builtin_amdgcn_rcpf(1.0f + __builtin_amdgcn_exp2f(-1.4426950408889634f * x)); }
__device__ __forceinline__ f32x4 silu4(f32x4 v) { f32x4 o; o[0] = silu_f(v[0]); o[1] = silu_f(v[1]); o[2] = silu_f(v[2]); o[3] = silu_f(v[3]); return o; }
__device__ __forceinline__ float log2g_of(int h) { return __builtin_amdgcn_logf(1.0f - __builtin_amdgcn_exp2f((float)(-5 - h))); }

struct EpiPlain {
    static constexpr bool PERM = true, AFTER_DRAIN = false;
    bf16_t* O; int ldc;
    __device__ __forceinline__ void operator()(const f32x4 (&acc)[2][2][4][2], const Unit& u, int wr, int wc, int fr, int fq) const {
        asm volatile("" : "+v"(fr), "+v"(fq));
        const int row0 = u.pm * BM + wr * 64 + fr, col0 = u.pn * BM + wc * 32 + 8 * fq;
#pragma unroll
        for (int ai = 0; ai < 2; ++ai)
#pragma unroll
            for (int m = 0; m < 4; ++m) { bf16_t* rowp = O + (size_t)(row0 + ai * HALF + m * 16) * ldc + col0;
#pragma unroll
                for (int bj = 0; bj < 2; ++bj) store8_bf16(rowp + bj * HALF, acc[ai][bj][m][0], acc[ai][bj][m][1]); }
    }
};

struct EpiInProj {
    static constexpr bool PERM = true, AFTER_DRAIN = false;
    unsigned char* ws; float* outp;
    __device__ __forceinline__ void operator()(const f32x4 (&acc)[2][2][4][2], const Unit& u, int wr, int wc, int fr, int fq) const {
        asm volatile("" : "+v"(fr), "+v"(fq));
        const float* rstd = (const float*)(ws + WS_RSTD); const float* rope = (const float*)(ws + WS_ROPE);
        bf16_t *QA = (bf16_t*)(ws + WS_QA), *KA = (bf16_t*)(ws + WS_KA), *VA = (bf16_t*)(ws + WS_VA), *QI = (bf16_t*)(ws + WS_QI), *KI = (bf16_t*)(ws + WS_KI), *GA = (bf16_t*)(ws + WS_GA);
        bf16_t *QB = (bf16_t*)(ws + WS_QB), *KB = (bf16_t*)(ws + WS_KB), *VB = (bf16_t*)(ws + WS_VB), *GB = (bf16_t*)(ws + WS_GB); float* WI = (float*)(ws + WS_WI);
        float *oK = outp + O_KP, *oV = outp + O_VP, *oKI = outp + O_KIP;
        const int row0 = u.pm * BM + wr * 64 + fr, cb = wc * 32 + 8 * fq, pn = u.pn;
#pragma unroll
        for (int ai = 0; ai < 2; ++ai)
#pragma unroll
            for (int m = 0; m < 4; ++m) {
                const int row = row0 + ai * HALF + m * 16; const float rs = rstd[row]; const int t = row & 2047;
#pragma unroll
                for (int bj = 0; bj < 2; ++bj) {
                    f32x4 v0 = acc[ai][bj][m][0] * rs, v1 = acc[ai][bj][m][1] * rs; const int c = bj * HALF + cb;
                    if (pn < 2) { const float C2 = 0.18033688011112042f; store8_bf16(QA + (size_t)row * 512 + pn * 256 + c, v0 * C2, v1 * C2); }
                    else if (pn == 2) { float* of = (bj ? oV : oK) + (size_t)row * 128 + cb; *(f32x4*)of = v0; *(f32x4*)(of + 4) = v1; store8_bf16((bj ? VA : KA) + (size_t)row * 128 + cb, v0, v1); }
                    else if (pn < 5) store8_bf16(QI + (size_t)row * 512 + (pn - 3) * 256 + c, v0, v1);
                    else if (pn == 5) {
                        if (bj == 0) {
                            if (cb < 64) { float* of = oKI + (size_t)row * 64 + cb; *(f32x4*)of = v0; *(f32x4*)(of + 4) = v1; store8_bf16(KI + (size_t)row * 64 + cb, v0, v1); }
                            else if (cb == 64) { const float WS = 0.04419417382415922f; float* of = WI + (size_t)row * 8; *(f32x4*)of = v0 * WS; *(f32x4*)(of + 4) = v1 * WS; }
                        }
                    }
                    else if (pn < 8) store8_bf16(GA + (size_t)row * 512 + (pn - 6) * 256 + c, silu4(v0), silu4(v1));
                    else if (pn < 12) {
                        const int f = ((pn & 1) ? 256 : 0) + c, hh = f >> 6, i0 = (f & 63) >> 1;
                        const f32x4 cs0 = *(const f32x4*)(rope + ((size_t)t * 32 + i0) * 2), cs1 = *(const f32x4*)(rope + ((size_t)t * 32 + i0) * 2 + 4);
                        const float e = (float)(t & 127) * log2g_of(hh);
                        const float sc = (pn < 10) ? __builtin_amdgcn_exp2f(e) : 0.125f * __builtin_amdgcn_exp2f(-e);
                        f32x4 o0, o1;
                        o0[0] = (v0[0] * cs0[0] - v0[1] * cs0[1]) * sc; o0[1] = (v0[0] * cs0[1] + v0[1] * cs0[0]) * sc;
                        o0[2] = (v0[2] * cs0[2] - v0[3] * cs0[3]) * sc; o0[3] = (v0[2] * cs0[3] + v0[3] * cs0[2]) * sc;
                        o1[0] = (v1[0] * cs1[0] - v1[1] * cs1[1]) * sc; o1[1] = (v1[0] * cs1[1] + v1[1] * cs1[0]) * sc;
                        o1[2] = (v1[2] * cs1[2] - v1[3] * cs1[3]) * sc; o1[3] = (v1[2] * cs1[3] + v1[3] * cs1[2]) * sc;
                        store8_bf16(((pn < 10) ? QB : KB) + (size_t)row * 512 + f, o0, o1);
                    }
                    else if (pn < 14) store8_bf16(VB + (size_t)row * 512 + (pn - 12) * 256 + c, v0, v1);
                    else store8_bf16(GB + (size_t)row * 512 + (pn - 14) * 256 + c, silu4(v0), silu4(v1));
                }
                asm volatile("" ::: "memory");
            }
    }
};

struct EpiRmsRes {
    static constexpr bool PERM = false, AFTER_DRAIN = true;
    const float* base; const float* gpost; float* out; bf16_t* xb; int ldc;
    unsigned* xbuf;
    unsigned* cnt;
    unsigned* tmo;
    float eps;
    __device__ __forceinline__ void fused(f32x4 (&acc)[2][2][4][2], const Unit& u, int wr, int wc, int fr, int fq, PG8_LAS unsigned char* lds, int wid, int lane) const {
        asm volatile("" : "+v"(fr), "+v"(fq));
        PG8_LAS float* P = (PG8_LAS float*)lds;
        PG8_LAS float* S = (PG8_LAS float*)(lds + 4096);
        PG8_LAS unsigned* flag = (PG8_LAS unsigned*)(lds + 4096 + 1024);
#pragma unroll
        for (int ai = 0; ai < 2; ++ai)
#pragma unroll
            for (int m = 0; m < 4; ++m) {
                float s = 0.f;
#pragma unroll
                for (int bj = 0; bj < 2; ++bj)
#pragma unroll
                    for (int n = 0; n < 2; ++n) { const f32x4 x = acc[ai][bj][m][n]; s += (x[0] * x[0] + x[1] * x[1]) + (x[2] * x[2] + x[3] * x[3]); }
                s += __shfl_xor(s, 16); s += __shfl_xor(s, 32);
                if (fq == 0) P[(ai * HALF + wr * 64 + m * 16 + fr) * 4 + wc] = s;
            }
        asm volatile("s_waitcnt lgkmcnt(0)" ::: "memory"); __builtin_amdgcn_s_barrier(); asm volatile("" ::: "memory");
        const int row = wid * 32 + (lane & 31);
        if (lane < 32) {
            const float tot = (P[row * 4 + 0] + P[row * 4 + 1]) + (P[row * 4 + 2] + P[row * 4 + 3]);
            unsigned long long* slot = (unsigned long long*)xbuf + ((size_t)(u.pm * BM + row) * 4 + u.pn);
            __hip_atomic_store(slot, (unsigned long long)__float_as_uint(tot), __ATOMIC_RELAXED, __HIP_MEMORY_SCOPE_AGENT);
        }
        asm volatile("s_waitcnt vmcnt(0)" ::: "memory");
        if (lane == 0) __hip_atomic_fetch_add(cnt + 64 * u.pm, 1u, __ATOMIC_RELAXED, __HIP_MEMORY_SCOPE_AGENT);
        if (wid == 0) {
            bool dead = false; const unsigned long long t0 = __builtin_amdgcn_s_memrealtime();
            for (;;) {
                if ((unsigned)__builtin_amdgcn_readfirstlane(__hip_atomic_load(cnt + 64 * u.pm, __ATOMIC_RELAXED, __HIP_MEMORY_SCOPE_AGENT)) >= 32u) break;
                if (__builtin_amdgcn_s_memrealtime() - t0 > 2000000ull) { if (lane == 0) __hip_atomic_store(tmo, 1u, __ATOMIC_RELAXED, __HIP_MEMORY_SCOPE_AGENT); dead = true; break; }
                __builtin_amdgcn_s_sleep(2);
            }
            __builtin_amdgcn_fence(__ATOMIC_ACQUIRE, "agent");
            if (lane == 0) flag[0] = dead ? 1u : 0u;
        }
        asm volatile("s_waitcnt vmcnt(0) lgkmcnt(0)" ::: "memory"); __builtin_amdgcn_s_barrier(); asm volatile("" ::: "memory");
        const bool bad = flag[0] != 0u;
        if (lane < 32) {
            const unsigned long long* slot = (const unsigned long long*)xbuf + (size_t)(u.pm * BM + row) * 4; float q = 0.f;
#pragma unroll
            for (int t = 0; t < 4; ++t) { const unsigned long long w = __hip_atomic_load(slot + t, __ATOMIC_RELAXED, __HIP_MEMORY_SCOPE_AGENT); q += __uint_as_float((unsigned)w); }
            S[row] = 1.0f / sqrtf(q * (1.0f / 1024.0f) + eps);
        }
        asm volatile("s_waitcnt lgkmcnt(0)" ::: "memory"); __builtin_amdgcn_s_barrier(); asm volatile("" ::: "memory");
        const float qnan = __builtin_nanf("");
        const int col0 = u.pn * BM + wc * 32 + 4 * fq;
#pragma unroll
        for (int ai = 0; ai < 2; ++ai)
#pragma unroll
            for (int m = 0; m < 4; ++m) { const int r = ai * HALF + wr * 64 + m * 16 + fr; const float sr = S[r]; const size_t off = (size_t)(u.pm * BM + r) * ldc + col0;
#pragma unroll
                for (int bj = 0; bj < 2; ++bj)
#pragma unroll
                    for (int n = 0; n < 2; ++n) { const f32x4 bs = *(const f32x4*)(base + off + bj * HALF + n * 16); const f32x4 gp = *(const f32x4*)(gpost + col0 + bj * HALF + n * 16);
                        f32x4 o = bs + acc[ai][bj][m][n] * sr * gp; if (bad) o = (f32x4){qnan, qnan, qnan, qnan};
                        *(f32x4*)(out + off + bj * HALF + n * 16) = o;
                        u32x2 w; w.x = cvt_pk_bf16(o[0], o[1]); w.y = cvt_pk_bf16(o[2], o[3]); *(u32x2*)(xb + off + bj * HALF + n * 16) = w; }
                if (m & 1) asm volatile("" ::: "memory"); }
    }
};

struct EpiGate {
    static constexpr bool PERM = false, AFTER_DRAIN = false;
    float* io; const bf16_t* ple; int ldc;
    __device__ __forceinline__ void operator()(const f32x4 (&acc)[2][2][4][2], const Unit& u, int wr, int wc, int fr, int fq) const {
        asm volatile("" : "+v"(fr), "+v"(fq));
        const int col0 = u.pn * BM + wc * 32 + 4 * fq;
#pragma unroll
        for (int ai = 0; ai < 2; ++ai)
#pragma unroll
            for (int m = 0; m < 4; ++m) { const size_t off = (size_t)(u.pm * BM + ai * HALF + wr * 64 + m * 16 + fr) * ldc + col0;
#pragma unroll
                for (int bj = 0; bj < 2; ++bj)
#pragma unroll
                    for (int n = 0; n < 2; ++n) { const size_t o2 = off + bj * HALF + n * 16; const f32x4 x1 = *(const f32x4*)(io + o2); const u32x2 pw = *(const u32x2*)(ple + o2); const f32x4 a = acc[ai][bj][m][n];
                        f32x4 o; o[0] = x1[0] + __uint_as_float(pw.x << 16) * sigmoid_f(a[0]); o[1] = x1[1] + __uint_as_float(pw.x & 0xffff0000u) * sigmoid_f(a[1]);
                        o[2] = x1[2] + __uint_as_float(pw.y << 16) * sigmoid_f(a[2]); o[3] = x1[3] + __uint_as_float(pw.y & 0xffff0000u) * sigmoid_f(a[3]);
                        *(f32x4*)(io + o2) = o; }
                if (m & 1) asm volatile("" ::: "memory"); }
    }
};

struct EpiF32 {
    static constexpr bool PERM = false, AFTER_DRAIN = false;
    float* O; int ldc;
    __device__ __forceinline__ void operator()(const f32x4 (&acc)[2][2][4][2], const Unit& u, int wr, int wc, int fr, int fq) const {
        asm volatile("" : "+v"(fr), "+v"(fq));
        const int col0 = u.pn * BM + wc * 32 + 4 * fq;
#pragma unroll
        for (int ai = 0; ai < 2; ++ai)
#pragma unroll
            for (int m = 0; m < 4; ++m) { const size_t off = (size_t)(u.pm * BM + ai * HALF + wr * 64 + m * 16 + fr) * ldc + col0;
#pragma unroll
                for (int bj = 0; bj < 2; ++bj)
#pragma unroll
                    for (int n = 0; n < 2; ++n) *(f32x4*)(O + off + bj * HALF + n * 16) = acc[ai][bj][m][n];
                asm volatile("" ::: "memory"); }
    }
};
template <class Epi, class Sched, bool ALIGN_EPI = false, bool SP2 = false, int KC = 0>
__device__ __forceinline__ void gemm_phase(PG8_LAS unsigned char* lds, const Gemm g, const Sched& S, const Epi& E, const int wid, const int lane) {
    const int tid = wid * 64 + lane, wr = wid >> 2, wc = wid & 3, fr = lane & 15, fq = lane >> 4;
    const int K = KC ? KC : g.K, nt = K / BK;
    unsigned voffA[2], voffB[2];
#pragma unroll
    for (int i = 0; i < 2; ++i) { int R, C; stage_rc(tid * 16 + i * 8192, R, C); const int Rb = Epi::PERM ? ((R & ~31) + perm32(R & 31)) : R;
        voffA[i] = (unsigned)(R * K + C) * 2u; voffB[i] = (unsigned)(Rb * K + C) * 2u; }
    const size_t kstep = (size_t)(BK * 2);
    const size_t hstep = (size_t)HALF * K * 2;
    const size_t tstep = 2 * hstep;
    const unsigned ldsw = (unsigned)wid * 1024u;
    const int aoff = lds_byte(wr * 64 + fr, fq * 8), boff = lds_byte(wc * 32 + fr, fq * 8);
#define PG8_SA(b, h) (((b) * 2 + (h)) * HTB)
#define PG8_SB(b, h) ((4 + (b) * 2 + (h)) * HTB)
#define PG8_STAGE(bufoff, gbase, voff) do { _Pragma("unroll") for (int _i = 0; _i < 2; ++_i) \
        __builtin_amdgcn_global_load_lds((const unsigned*)((const char*)(gbase) + (voff)[_i]), (PG8_LAS unsigned*)(lds + (bufoff) + ldsw + _i * 8192), 16, 0, 0); } while (0)
#define PG8_LDA(dst, b, h) do { _Pragma("unroll") for (int m = 0; m < 4; ++m) _Pragma("unroll") for (int k = 0; k < 2; ++k) dst[m][k] = *(const PG8_LAS bf16x8*)(lds + PG8_SA(b, h) + aoff + m * 2048 + k * 1024); } while (0)
#define PG8_LDB(dst, b, h) do { _Pragma("unroll") for (int n = 0; n < 2; ++n) _Pragma("unroll") for (int k = 0; k < 2; ++k) dst[n][k] = *(const PG8_LAS bf16x8*)(lds + PG8_SB(b, h) + boff + n * 2048 + k * 1024); } while (0)
#define PG8_MMA(ai, bj, At, Bt) do { __builtin_amdgcn_s_setprio(1); _Pragma("unroll") for (int m = 0; m < 4; ++m) _Pragma("unroll") for (int n = 0; n < 2; ++n) _Pragma("unroll") for (int k = 0; k < 2; ++k) \
        acc[ai][bj][m][n] = __builtin_amdgcn_mfma_f32_16x16x32_bf16(Bt[n][k], At[m][k], acc[ai][bj][m][n], 0, 0, 0); __builtin_amdgcn_s_setprio(0); } while (0)
#define PG8_WAIT_V(n) asm volatile("s_waitcnt vmcnt(" #n ")" ::: "memory")
#define PG8_WAIT_L(n) asm volatile("s_waitcnt lgkmcnt(" #n ")" ::: "memory")
#define PG8_BAR __builtin_amdgcn_s_barrier()
#define PG8_SCHED __builtin_amdgcn_sched_barrier(0)
    Unit cur, nxt; int ui = 0;
    if (!S.next(0, cur)) return;
    f32x4 acc[2][2][4][2];
#pragma unroll
    for (int a = 0; a < 2; ++a)
#pragma unroll
        for (int b = 0; b < 2; ++b)
#pragma unroll
            for (int m = 0; m < 4; ++m)
#pragma unroll
                for (int n = 0; n < 2; ++n) acc[a][b][m][n] = (f32x4){0.f, 0.f, 0.f, 0.f};
    bf16x8 At[4][2], B0[2][2], B1[2][2];
    const char* cA = (const char*)g.A + (size_t)cur.pm * tstep; const char* cB = (const char*)g.Bt + (size_t)cur.pn * tstep;
    S.a_ready(cur);
    if constexpr (SP2) {
        PG8_STAGE(PG8_SB(0, 0), cB, voffB); PG8_STAGE(PG8_SB(0, 1), cB + hstep, voffB); PG8_STAGE(PG8_SA(0, 0), cA, voffA); PG8_STAGE(PG8_SA(0, 1), cA + hstep, voffA);
        if (wr == 1) PG8_BAR;
        PG8_WAIT_V(2); PG8_BAR;
        PG8_STAGE(PG8_SB(1, 0), cB + kstep, voffB); PG8_STAGE(PG8_SA(1, 0), cA + kstep, voffA); PG8_STAGE(PG8_SB(1, 1), cB + hstep + kstep, voffB);
        PG8_WAIT_V(6); PG8_BAR;
    } else {
        PG8_STAGE(PG8_SB(0, 0), cB, voffB); PG8_STAGE(PG8_SA(0, 0), cA, voffA); PG8_STAGE(PG8_SB(0, 1), cB + hstep, voffB); PG8_STAGE(PG8_SA(0, 1), cA + hstep, voffA);
        if (wr == 1) PG8_BAR;
        PG8_WAIT_V(4); PG8_BAR;
        PG8_STAGE(PG8_SB(1, 0), cB + kstep, voffB); PG8_STAGE(PG8_SA(1, 0), cA + kstep, voffA); PG8_STAGE(PG8_SB(1, 1), cB + hstep + kstep, voffB);
        PG8_WAIT_V(6); PG8_BAR;
    }
    for (;;) {
        const bool has_next = S.next(ui + 1, nxt);
        const char* nA = has_next ? (const char*)g.A + (size_t)nxt.pm * tstep : cA; const char* nB = has_next ? (const char*)g.Bt + (size_t)nxt.pn * tstep : cB;
        for (int t = 0; t < nt; t += 2) {
            const bool last = (t == nt - 2);
            const char* a1 = cA + (size_t)(t + 1) * kstep;
            const char* a2 = last ? nA : cA + (size_t)(t + 2) * kstep; const char* b2 = last ? nB : cB + (size_t)(t + 2) * kstep;
            const char* a3 = a2 + kstep; const char* b3 = b2 + kstep;
            if (last && has_next) S.a_ready(nxt);
            if constexpr (SP2) {
            PG8_LDB(B0, 0, 0); PG8_LDB(B1, 0, 1); PG8_SCHED; PG8_LDA(At, 0, 0); PG8_STAGE(PG8_SA(1, 1), a1 + hstep, voffA);
            PG8_WAIT_V(8); PG8_WAIT_L(0); PG8_BAR; PG8_MMA(0, 0, At, B0); PG8_MMA(0, 1, At, B1); PG8_BAR; PG8_SCHED;
            PG8_LDA(At, 0, 1); PG8_STAGE(PG8_SB(0, 0), b2, voffB); PG8_STAGE(PG8_SB(0, 1), b2 + hstep, voffB); PG8_STAGE(PG8_SA(0, 0), a2, voffA);
            PG8_WAIT_V(8); PG8_WAIT_L(0); PG8_BAR; PG8_MMA(1, 0, At, B0); PG8_MMA(1, 1, At, B1); PG8_BAR; PG8_SCHED;
            PG8_LDB(B0, 1, 0); PG8_LDB(B1, 1, 1); PG8_SCHED; PG8_LDA(At, 1, 0); PG8_STAGE(PG8_SA(0, 1), a2 + hstep, voffA);
            PG8_WAIT_V(8); PG8_WAIT_L(0); PG8_BAR; PG8_MMA(0, 0, At, B0); PG8_MMA(0, 1, At, B1); PG8_BAR; PG8_SCHED;
            PG8_LDA(At, 1, 1); PG8_STAGE(PG8_SB(1, 0), b3, voffB); PG8_STAGE(PG8_SB(1, 1), b3 + hstep, voffB); PG8_STAGE(PG8_SA(1, 0), a3, voffA);
            PG8_WAIT_V(8); PG8_WAIT_L(0); PG8_BAR; PG8_MMA(1, 0, At, B0); PG8_MMA(1, 1, At, B1); PG8_BAR; PG8_SCHED;
            } else {
            PG8_LDB(B0, 0, 0); PG8_SCHED; PG8_LDA(At, 0, 0); PG8_STAGE(PG8_SA(1, 1), a1 + hstep, voffA);
            PG8_WAIT_L(8); PG8_BAR; PG8_WAIT_L(0); PG8_MMA(0, 0, At, B0); PG8_BAR; PG8_SCHED;
            PG8_LDB(B1, 0, 1); PG8_STAGE(PG8_SB(0, 0), b2, voffB);
            PG8_BAR; PG8_WAIT_L(0); PG8_MMA(0, 1, At, B1); PG8_BAR;
            PG8_LDA(At, 0, 1); PG8_STAGE(PG8_SA(0, 0), a2, voffA);
            PG8_BAR; PG8_WAIT_L(0); PG8_MMA(1, 0, At, B0); PG8_BAR; PG8_SCHED;
            PG8_STAGE(PG8_SB(0, 1), b2 + hstep, voffB);
            PG8_WAIT_V(6); PG8_BAR; PG8_MMA(1, 1, At, B1); PG8_BAR;
            PG8_LDB(B0, 1, 0); PG8_SCHED; PG8_LDA(At, 1, 0); PG8_STAGE(PG8_SA(0, 1), a2 + hstep, voffA);
            PG8_WAIT_L(8); PG8_BAR; PG8_WAIT_L(0); PG8_MMA(0, 0, At, B0); PG8_BAR; PG8_SCHED;
            PG8_LDB(B1, 1, 1); PG8_STAGE(PG8_SB(1, 0), b3, voffB);
            PG8_BAR; PG8_WAIT_L(0); PG8_MMA(0, 1, At, B1); PG8_BAR;
            PG8_LDA(At, 1, 1); PG8_STAGE(PG8_SA(1, 0), a3, voffA);
            PG8_BAR; PG8_WAIT_L(0); PG8_MMA(1, 0, At, B0); PG8_BAR; PG8_SCHED;
            PG8_STAGE(PG8_SB(1, 1), b3 + hstep, voffB);
            PG8_WAIT_V(6); PG8_BAR; PG8_MMA(1, 1, At, B1); PG8_BAR;
            }
        }
        if constexpr (ALIGN_EPI) { if (wr == 0) PG8_BAR; }
        if constexpr (!Epi::AFTER_DRAIN) { E(acc, cur, wr, wc, fr, fq); S.done(cur); }
        if (!has_next) break;
#pragma unroll
        for (int a = 0; a < 2; ++a)
#pragma unroll
            for (int b = 0; b < 2; ++b)
#pragma unroll
                for (int m = 0; m < 4; ++m)
#pragma unroll
                    for (int n = 0; n < 2; ++n) acc[a][b][m][n] = (f32x4){0.f, 0.f, 0.f, 0.f};
        cur = nxt; cA = nA; cB = nB; ++ui;
        if constexpr (ALIGN_EPI) { if (wr == 1) PG8_BAR; }
    }
    PG8_WAIT_V(0);
    if constexpr (!ALIGN_EPI) { if (wr == 0) PG8_BAR; }
    PG8_BAR;
    if constexpr (Epi::AFTER_DRAIN) { E.fused(acc, cur, wr, wc, fr, fq, lds, wid, lane); S.done(cur); }
#undef PG8_SA
#undef PG8_SB
#undef PG8_STAGE
#undef PG8_LDA
#undef PG8_LDB
#undef PG8_MMA
#undef PG8_WAIT_V
#undef PG8_WAIT_L
#undef PG8_BAR
#undef PG8_SCHED
}
}
#define GAS __attribute__((address_space(1)))
#define LAS __attribute__((address_space(3)))
typedef unsigned short bf16;
typedef unsigned v4u __attribute__((ext_vector_type(4)));
typedef float f32x4 __attribute__((ext_vector_type(4)));
typedef short bf16x8 __attribute__((ext_vector_type(8)));
typedef GAS unsigned gu32;
typedef GAS unsigned long long gu64;
#define RLX_AGENT __ATOMIC_RELAXED, __HIP_MEMORY_SCOPE_AGENT
#define LDS_WAIT() asm volatile("s_waitcnt lgkmcnt(0)" ::: "memory")
#define VM_WAIT() asm volatile("s_waitcnt vmcnt(0)" ::: "memory")
__device__ __forceinline__ unsigned long long rt() { return __builtin_amdgcn_s_memrealtime(); }
__device__ __forceinline__ unsigned f2bf(float f) { unsigned u = __builtin_bit_cast(unsigned, f); return (u + 0x7fffu + ((u >> 16) & 1u)) >> 16; }
__device__ __forceinline__ unsigned pk2(float lo, float hi) { return f2bf(lo) | (f2bf(hi) << 16); }
#define XB_TMO      128
#define XB_XCNT(j)  (256  + 64 * (j))
#define XB_XSUB(j)  (1280 + 64 * (j))
#define XB_XGEN(j)  (2304 + 64 * (j))
#define XB_TOP      3328
#define XB_TOPGEN   3392
#define XCD_BAR_WORDS 3456
#define XB_SPIN_CAP (1u << 18)

__device__ __forceinline__ unsigned xb_ld(unsigned* p)              { return __hip_atomic_load(p, __ATOMIC_RELAXED, __HIP_MEMORY_SCOPE_AGENT); }
__device__ __forceinline__ unsigned xb_add(unsigned* p, unsigned v) { return __hip_atomic_fetch_add(p, v, __ATOMIC_RELAXED, __HIP_MEMORY_SCOPE_AGENT); }
__device__ __forceinline__ unsigned xb_xcc_id() { return (unsigned)__builtin_amdgcn_s_getreg((3 << 11) | 20) & 0xFu; }
#define XB_SPIN(cond, bar) do { unsigned _sp = 0; while (cond) { __builtin_amdgcn_s_sleep(1); \
    if ((++_sp & 255u) == 0u) { if (xb_ld(&(bar)[XB_TMO])) break; if (_sp > XB_SPIN_CAP) { atomicAdd(&(bar)[XB_TMO], 1u); break; } } } } while (0)

struct XcdBarrier {
    unsigned* bar; unsigned x;
    volatile LAS unsigned* st;
};

__device__ __forceinline__ XcdBarrier xcd_barrier_post(unsigned* bar, volatile LAS unsigned* st, bool t0) {
    XcdBarrier b; b.bar = bar; b.x = xb_xcc_id(); b.st = st;
    if (t0) (void)xb_add(&bar[XB_XCNT(b.x)], 1u);
    return b;
}
__device__ __forceinline__ void xcd_barrier_complete(unsigned* bar, unsigned x, unsigned& nloc, unsigned& nx) {
    const unsigned G = gridDim.x * gridDim.y * gridDim.z;
    unsigned sum, cnt, mine, sp = 0u;
    for (;;) {
        sum = 0u; cnt = 0u; mine = 0u;
#pragma unroll
        for (unsigned j = 0; j < 16; ++j) { const unsigned c = xb_ld(&bar[XB_XCNT(j)]); sum += c; cnt += (c > 0u) ? 1u : 0u; mine = (j == x) ? c : mine; }
        if (sum == G) break;
        __builtin_amdgcn_s_sleep(1);
        if ((++sp & 255u) == 0u) { if (xb_ld(&bar[XB_TMO])) break; if (sp > XB_SPIN_CAP) { atomicAdd(&bar[XB_TMO], 1u); break; } }
    }
    nloc = mine > 0u ? mine : 1u; nx = cnt > 0u ? cnt : 1u;
}

__device__ __forceinline__ void xcd_barrier(const XcdBarrier& b, bool t0) {
    asm volatile("s_waitcnt vmcnt(0)" ::: "memory");
    __syncthreads();
    if (t0) {
        unsigned* bar = b.bar;
        __builtin_amdgcn_s_waitcnt(0);
        unsigned nloc = b.st[0], nx = b.st[1];
        if (nloc == 0u) { xcd_barrier_complete(bar, b.x, nloc, nx); b.st[0] = nloc; b.st[1] = nx; }
        const unsigned old = xb_add(&bar[XB_XSUB(b.x)], 1u);
        const unsigned gen = old / nloc;
        if (old + 1u == (gen + 1u) * nloc) {
            __builtin_amdgcn_fence(__ATOMIC_RELEASE, "agent");
            asm volatile("s_waitcnt vmcnt(0)" ::: "memory");
            const unsigned og = xb_add(&bar[XB_TOP], 1u);
            const unsigned tg = og / nx;
            if (og + 1u == (tg + 1u) * nx) xb_add(&bar[XB_TOPGEN], 1u);
            else XB_SPIN(xb_ld(&bar[XB_TOPGEN]) == tg, bar);
            __builtin_amdgcn_fence(__ATOMIC_ACQUIRE, "agent");
            xb_add(&bar[XB_XGEN(b.x)], 1u);
            asm volatile("s_waitcnt vmcnt(0)" ::: "memory");
        } else {
            XB_SPIN(xb_ld(&bar[XB_XGEN(b.x)]) == gen, bar);
            __builtin_amdgcn_fence(__ATOMIC_ACQUIRE, "agent");
            asm volatile("s_waitcnt vmcnt(0)" ::: "memory");
        }
    }
    __syncthreads();
}

typedef float f32x16 __attribute__((ext_vector_type(16)));
typedef float f32x2v __attribute__((ext_vector_type(2)));
typedef unsigned u32x2v __attribute__((ext_vector_type(2)));
typedef short s16x4 __attribute__((ext_vector_type(4)));
#define MFMA32(a, b, c) __builtin_amdgcn_mfma_f32_32x32x16_bf16((a), (b), (c), 0, 0, 0)
#define MFMA16(a, b, c) __builtin_amdgcn_mfma_f32_16x16x32_bf16((a), (b), (c), 0, 0, 0)
__device__ __forceinline__ unsigned cvtpk(float lo, float hi) { return pg8::cvt_pk_bf16_c(lo, hi); }
__device__ __forceinline__ bf16x8 pack8(f32x4 a, f32x4 b) { v4u w; w.x = cvtpk(a[0], a[1]); w.y = cvtpk(a[2], a[3]); w.z = cvtpk(b[0], b[1]); w.w = cvtpk(b[2], b[3]); return __builtin_bit_cast(bf16x8, w); }
__device__ __forceinline__ float bf_lo(unsigned w) { return __uint_as_float(w << 16); }
__device__ __forceinline__ float bf_hi(unsigned w) { return __uint_as_float(w & 0xffff0000u); }
__device__ __forceinline__ int lane_id() { int l; asm volatile("v_mbcnt_lo_u32_b32 %0, -1, 0\n\tv_mbcnt_hi_u32_b32 %0, -1, %0" : "=v"(l)); return l; }
__device__ __forceinline__ int crow(int reg, int h) { return (reg & 3) + 8 * (reg >> 2) + 4 * h; }

struct Params {
    const float *x_p, *x_s, *cache_k, *cache_v, *cache_kidx, *state_ret; const int* page_table;
    const float *p_p, *p_s, *rel_bias, *w_in, *w_out, *g_pre, *g_post, *w_up, *w_gate;
    float* out; unsigned char* ws;
    int ph_lo, ph_hi;
};

__device__ __forceinline__ int win_src_col(int n) {
    if (n < 1352) return n;
    if (n < 1536) return -1;
    if (n < 2048) return C_GA + (n - 1536);
    if (n < 3072) { const int base = (n < 2560) ? C_QB : C_KB; const int f = (n - 2048) & 511, hh = f >> 6, p = f & 63, d = (p & 1) ? 32 + (p >> 1) : (p >> 1); return base + hh * 64 + d; }
    if (n < 3584) return C_VB + (n - 3072);
    return C_GB + (n - 3584);
}
__device__ __forceinline__ void p0_transpose_item(const float* W, int ldw, int K, const float* gk, bf16* WT, int kb, int nb, int srccol, LAS float* scr, int lane) {
    const int k0 = 64 * kb, n0 = 32 * nb;
#pragma unroll 8
    for (int i = 0; i < 32; ++i) { const int kk = 2 * i + (lane >> 5); float v = 0.f; if (srccol >= 0) v = W[(size_t)(k0 + kk) * ldw + srccol]; if (gk) v *= gk[k0 + kk]; scr[kk * 33 + (lane & 31)] = v; }
    LDS_WAIT(); asm volatile("" ::: "memory");
    const int c = lane & 7;
#pragma unroll
    for (int j = 0; j < 4; ++j) { const int n = (lane >> 3) + 8 * j; const LAS float* s = scr + (8 * c) * 33 + n;
        v4u o; o.x = cvtpk(s[0 * 33], s[1 * 33]); o.y = cvtpk(s[2 * 33], s[3 * 33]); o.z = cvtpk(s[4 * 33], s[5 * 33]); o.w = cvtpk(s[6 * 33], s[7 * 33]);
        *(GAS v4u*)(WT + (size_t)(n0 + n) * K + k0 + 8 * c) = o; }
    LDS_WAIT(); asm volatile("" ::: "memory");
}
__device__ __forceinline__ float wave_sum(float v) {
#pragma unroll
    for (int o = 1; o < 64; o <<= 1) v += __shfl_xor(v, o);
    return v;
}
__device__ __forceinline__ void sincos_d(double a, double& s, double& c) {
    const double TWO_PI = 6.283185307179586476925286766559, INV_2PI = 0.15915494309189533576888376337251;
    const double n = __builtin_rint(a * INV_2PI); double r = __builtin_fma(-n, TWO_PI, a); r = __builtin_fma(-n, 2.4492935982947064e-16, r);
    const double r2 = r * r; double ts = 1.0, tc = 1.0, ss = 1.0, cc = 1.0;
#pragma unroll
    for (int k = 1; k <= 14; ++k) { tc = -tc * r2 / (double)((2 * k - 1) * (2 * k)); cc += tc; ts = -ts * r2 / (double)((2 * k) * (2 * k + 1)); ss += ts; }
    s = r * ss; c = cc;
}
__device__ __forceinline__ void p0_sample_inproj(const Params& P, int unit, int wave, int lane) {
    const int col = unit * 16 + (lane & 15); const bool cv = col < D_IN; const int kg = lane >> 4, row = wave * 16 + (lane & 15);
    const float* xr = P.x_s + (size_t)row * DM; const float* wc = P.w_in + (cv ? col : 0);
    f32x4 acc = {0.f, 0.f, 0.f, 0.f}; float ss = 0.f;
#pragma unroll 2
    for (int ks = 0; ks < 32; ++ks) { const int k0 = 32 * ks + 8 * kg;
        const f32x4 xa = *(const f32x4*)(xr + k0), xb = *(const f32x4*)(xr + k0 + 4), ga = *(const f32x4*)(P.g_pre + k0), gb = *(const f32x4*)(P.g_pre + k0 + 4);
        ss += (xa[0] * xa[0] + xa[1] * xa[1]) + (xa[2] * xa[2] + xa[3] * xa[3]) + (xb[0] * xb[0] + xb[1] * xb[1]) + (xb[2] * xb[2] + xb[3] * xb[3]);
        const bf16x8 a = pack8(xa * ga, xb * gb);
        float wv[8];
#pragma unroll
        for (int j = 0; j < 8; ++j) wv[j] = cv ? wc[(size_t)(k0 + j) * D_IN] : 0.f;
        const bf16x8 b = pack8((f32x4){wv[0], wv[1], wv[2], wv[3]}, (f32x4){wv[4], wv[5], wv[6], wv[7]});
        acc = MFMA16(a, b, acc); }
    ss += __shfl_xor(ss, 16); ss += __shfl_xor(ss, 32);
    const float rstd = 1.0f / sqrtf(ss * (1.0f / DM) + EPS);
#pragma unroll
    for (int j = 0; j < 4; ++j) { const int r = kg * 4 + j; const float rs = __shfl(rstd, r); const float z = acc[j] * rs; const int grow = wave * 16 + r;
        if (cv) { float* zs = (float*)(P.ws + WS_ZS); zs[(size_t)grow * D_IN + col] = z;
            if (col >= C_KA && col < C_VA) P.out[O_KS + (size_t)grow * 128 + (col - C_KA)] = z;
            else if (col >= C_VA && col < C_QI) P.out[O_VS + (size_t)grow * 128 + (col - C_VA)] = z;
            else if (col >= C_KI && col < C_WI) P.out[O_KIS + (size_t)grow * 64 + (col - C_KI)] = z; } }
}
__device__ __forceinline__ int t5_bucket(int n) {
    if (n < 16) return n;
    const int l = 16 + (int)(__builtin_amdgcn_logf((float)n * 0.0625f) * (16.0f / 3.0f) + 1e-4f);
    return l < 31 ? l : 31;
}
__device__ __forceinline__ void p0_prologue(const Params& P, LAS unsigned char* lds, int vcu, int G, int wave, int lane, int tid) {
    LAS float* scr = (LAS float*)(lds + wave * 16384);
    const int gw = vcu * NWAVES + wave, NGW = G * NWAVES;
    bf16* win_t = (bf16*)(P.ws + WS_WIN); bf16* wout_t = (bf16*)(P.ws + WS_WOUT); bf16* wgate_t = (bf16*)(P.ws + WS_WGATE); bf16* wup_t = (bf16*)(P.ws + WS_WUP);
    constexpr int I_IN = (DM / 64) * (NPAD / 32), I_SQ = (DM / 64) * (DM / 32), I_UP = (DPLE / 64) * (DM / 32);
    constexpr int NITEMS = I_IN + 2 * I_SQ + I_UP;
    for (int it = gw; it < NITEMS; it += NGW) {
        int r = it;
        if (r < I_IN) { const int nblk = NPAD / 32, kb = r / nblk, nb = r % nblk; p0_transpose_item(P.w_in, D_IN, DM, P.g_pre, win_t, kb, nb, win_src_col(nb * 32 + (lane & 31)), scr, lane); continue; } r -= I_IN;
        if (r < I_SQ) { const int nblk = DM / 32, kb = r / nblk, nb = r % nblk; p0_transpose_item(P.w_out, DM, DM, nullptr, wout_t, kb, nb, nb * 32 + (lane & 31), scr, lane); continue; } r -= I_SQ;
        if (r < I_SQ) { const int nblk = DM / 32, kb = r / nblk, nb = r % nblk; p0_transpose_item(P.w_gate, DM, DM, nullptr, wgate_t, kb, nb, nb * 32 + (lane & 31), scr, lane); continue; } r -= I_SQ;
        { const int nblk = DM / 32, kb = r / nblk, nb = r % nblk; p0_transpose_item(P.w_up, DM, DPLE, nullptr, wup_t, kb, nb, nb * 32 + (lane & 31), scr, lane); }
    }
    bf16* xb = (bf16*)(P.ws + WS_XB); float* rstd = (float*)(P.ws + WS_RSTD);
    for (int m = gw; m < M; m += NGW) {
        const GAS f32x4* xr = (const GAS f32x4*)(P.x_p + (size_t)m * DM) + lane;
        f32x4 v[4]; float s = 0.f;
#pragma unroll
        for (int j = 0; j < 4; ++j) { v[j] = xr[64 * j]; s += (v[j].x * v[j].x + v[j].y * v[j].y) + (v[j].z * v[j].z + v[j].w * v[j].w); }
        s = wave_sum(s);
        GAS u32x2v* o8 = (GAS u32x2v*)(xb + (size_t)m * DM) + lane;
#pragma unroll
        for (int j = 0; j < 4; ++j) { u32x2v w; w.x = cvtpk(v[j].x, v[j].y); w.y = cvtpk(v[j].z, v[j].w); o8[64 * j] = w; }
        if (lane == 0) rstd[m] = 1.0f / sqrtf(s * (1.0f / DM) + EPS);
    }
    { bf16* pb = (bf16*)(P.ws + WS_PB); const int NT = G * NWAVES * 64, gt = gw * 64 + lane;
      for (int i = gt; i < M * DPLE / 8; i += NT) { const f32x4 a = *(const f32x4*)(P.p_p + (size_t)i * 8), b = *(const f32x4*)(P.p_p + (size_t)i * 8 + 4); *(bf16x8*)(pb + (size_t)i * 8) = pack8(a, b); }
      float* rope = (float*)(P.ws + WS_ROPE);
      for (int i = gt; i < 2052 * 32; i += NT) { const int p = i >> 5, fi = i & 31; const int pos = p < 2048 ? p : PAST + (p - 2048);
          const float inv = (float)exp2(-(double)fi * (13.287712379549449 / 32.0));
          const float ang = (float)pos * inv; double s, c; sincos_d((double)ang, s, c); rope[(size_t)i * 2] = (float)c; rope[(size_t)i * 2 + 1] = (float)s; }
      float* bias2 = (float*)(P.ws + WS_BIAS);
      for (int i = gt; i < 128 * 8; i += NT) { const int n = i >> 3, hd = i & 7; bias2[i] = P.rel_bias[t5_bucket(n) * 8 + hd] * LOG2E; }
    }
    if (vcu < (D_IN + 15) / 16) p0_sample_inproj(P, vcu, wave, lane);
}

__device__ __forceinline__ void p1_sample_index(const Params& P, int unit, int wave, int lane) {
    const int b = unit >> 3, js = unit & 7, r = lane & 31, h = lane >> 5;
    const float* zs = (const float*)(P.ws + WS_ZS); float* scs = (float*)(P.ws + WS_SCS);
    const int cq = (r >> 2) & 1, a = r >> 3, e = r & 3, q = 2 * cq + (a >> 1), hd = 4 * (a & 1) + e;
    const float* zq = zs + (size_t)(b * 4 + q) * D_IN + C_QI + hd * 64 + 32 * h;
    bf16x8 af[4];
#pragma unroll
    for (int s = 0; s < 4; ++s) af[s] = pack8(*(const f32x4*)(zq + 8 * s), *(const f32x4*)(zq + 8 * s + 4));
    float w[16];
#pragma unroll
    for (int i = 0; i < 16; ++i) w[i] = zs[(size_t)(b * 4 + 2 * h + (i >> 3)) * D_IN + C_WI + (i & 7)] * WSCALE;
    for (int pi = 0; pi < 2; ++pi) {
        const int lp = js * 16 + wave * 2 + pi; const int phys = P.page_table[b * NPG + lp];
        const float* kp = P.cache_kidx + (size_t)phys * PAGE * 64;
#pragma unroll 2
        for (int tile = 0; tile < 4; ++tile) {
            const float* kr = kp + (size_t)(tile * 32 + r) * 64 + 32 * h;
            f32x4 kv[8];
#pragma unroll
            for (int j = 0; j < 8; ++j) kv[j] = *(const f32x4*)(kr + 4 * j);
            f32x16 acc = {};
#pragma unroll
            for (int s = 0; s < 4; ++s) acc = MFMA32(af[s], pack8(kv[2 * s], kv[2 * s + 1]), acc);
            float s0 = 0.f, s1 = 0.f;
#pragma unroll
            for (int i = 0; i < 8; ++i) { s0 += w[i] * fmaxf(acc[i], 0.f); s1 += w[8 + i] * fmaxf(acc[8 + i], 0.f); }
            const int pos = lp * PAGE + tile * 32 + r;
            scs[(size_t)(b * 4 + 2 * h) * PAST + pos] = s0; scs[(size_t)(b * 4 + 2 * h + 1) * PAST + pos] = s1;
        }
    }
}

__device__ __forceinline__ float bfu(bf16 v) { return __uint_as_float((unsigned)v << 16); }
__device__ __forceinline__ unsigned fkey(float x) { const unsigned u = __float_as_uint(x); return (u & 0x80000000u) ? ~u : (u | 0x80000000u); }
__device__ __forceinline__ float block_sum(float v, LAS float* red, int wave, int lane) {
    v = wave_sum(v); if (lane == 0) red[wave] = v; __syncthreads();
    float s = 0.f;
#pragma unroll
    for (int w = 0; w < NWAVES; ++w) s += red[w];
    __syncthreads(); return s;
}

__device__ __forceinline__ void np2_dsa_query(const Params& P, LAS unsigned char* lds, int m, int tid, int wave, int lane) {
    const int b = m >> 11, t = m & 2047, nk = t + 1;
    LAS float* sc = (LAS float*)lds; LAS float* qi = sc + 2048; LAS float* wi = qi + 512; LAS int* sel = (LAS int*)(wi + 8); LAS int* nselp = sel + 256;
    LAS float* lg = (LAS float*)(nselp + 8); LAS float* qa = lg + 2048; LAS float* red = qa + 512;
    const bf16* QI = (const bf16*)(P.ws + WS_QI); const bf16* KI = (const bf16*)(P.ws + WS_KI); const float* WI = (const float*)(P.ws + WS_WI);
    const bf16* QA = (const bf16*)(P.ws + WS_QA); const bf16* KA = (const bf16*)(P.ws + WS_KA); const bf16* VA = (const bf16*)(P.ws + WS_VA); const bf16* GA = (const bf16*)(P.ws + WS_GA);
    const float* bias2 = (const float*)(P.ws + WS_BIAS); bf16* YM = (bf16*)(P.ws + WS_YM);
    qi[tid] = bfu(QI[(size_t)m * 512 + tid]); qa[tid] = bfu(QA[(size_t)m * 512 + tid]); if (tid < 8) wi[tid] = WI[(size_t)m * 8 + tid]; if (tid == 0) nselp[0] = 0;
    __syncthreads();
    for (int s = tid; s < nk; s += 512) {
        const bf16* kr = KI + (size_t)(b * T + s) * 64; float kf[64];
#pragma unroll
        for (int j = 0; j < 8; ++j) { const v4u w = *(const v4u*)(kr + 8 * j); kf[8 * j] = bf_lo(w.x); kf[8 * j + 1] = bf_hi(w.x); kf[8 * j + 2] = bf_lo(w.y); kf[8 * j + 3] = bf_hi(w.y); kf[8 * j + 4] = bf_lo(w.z); kf[8 * j + 5] = bf_hi(w.z); kf[8 * j + 6] = bf_lo(w.w); kf[8 * j + 7] = bf_hi(w.w); }
        float score = 0.f;
        for (int hd = 0; hd < 8; ++hd) { float d = 0.f;
#pragma unroll
            for (int j = 0; j < 64; ++j) d += qi[hd * 64 + j] * kf[j];
            score += wi[hd] * fmaxf(d, 0.f); }
        sc[s] = score;
    }
    __syncthreads();
    int nsel;
    if (nk <= 256) { for (int s = tid; s < nk; s += 512) sel[s] = s; nsel = nk; }
    else {
        for (int s = tid; s < nk; s += 512) { const float x = sc[s]; int rank = 0;
            for (int s2 = 0; s2 < nk; ++s2) { const float y = sc[s2]; rank += (y > x || (y == x && s2 < s)) ? 1 : 0; }
            if (rank < 256) { const int pos = atomicAdd((int*)nselp, 1); sel[pos] = s; } }
        nsel = 256;
    }
    __syncthreads();
    for (int idx = tid; idx < 8 * nsel; idx += 512) { const int hd = idx & 7, k = idx >> 3, s = sel[k]; const bf16* kr = KA + (size_t)(b * T + s) * 128 + (hd >> 2) * 64; float d = 0.f;
#pragma unroll
        for (int j = 0; j < 8; ++j) { const v4u w = *(const v4u*)(kr + 8 * j); const LAS float* q = qa + hd * 64 + 8 * j;
            d += q[0] * bf_lo(w.x) + q[1] * bf_hi(w.x) + q[2] * bf_lo(w.y) + q[3] * bf_hi(w.y) + q[4] * bf_lo(w.z) + q[5] * bf_hi(w.z) + q[6] * bf_lo(w.w) + q[7] * bf_hi(w.w); }
        const int dist = t - s; lg[hd * 256 + k] = d + bias2[(dist < 127 ? dist : 127) * 8 + hd]; }
    __syncthreads();
    { const int hd = wave; float mx = -3.0e38f; for (int k = lane; k < nsel; k += 64) mx = fmaxf(mx, lg[hd * 256 + k]);
#pragma unroll
      for (int o = 1; o < 64; o <<= 1) mx = fmaxf(mx, __shfl_xor(mx, o));
      float sum = 0.f; for (int k = lane; k < nsel; k += 64) { const float p = __builtin_amdgcn_exp2f(lg[hd * 256 + k] - mx); lg[hd * 256 + k] = p; sum += p; }
      sum = wave_sum(sum); if (lane == 0) red[hd] = 1.0f / sum; }
    __syncthreads();
    { const int hd = tid >> 6, d = tid & 63; float acc = 0.f;
      for (int k = 0; k < nsel; ++k) acc += lg[hd * 256 + k] * bfu(VA[(size_t)(b * T + sel[k]) * 128 + (hd >> 2) * 64 + d]);
      const float o = acc * red[hd] * bfu(GA[(size_t)m * 512 + tid]);
      YM[(size_t)m * DM + tid] = (bf16)(cvtpk(o, 0.f) & 0xffffu); }
    __syncthreads();
}

__device__ __forceinline__ void np2_ret_block(const Params& P, LAS unsigned char* lds, int unit, int tid, int wave, int lane) {
    const int tb = unit & 255, h = (unit >> 8) & 7, b = unit >> 11; const int tl = tid >> 6, dv = tid & 63, t = tb * 8 + tl, m = b * T + t;
    LAS float* qs = (LAS float*)lds; LAS float* wts = qs + 512;
    const bf16* QB = (const bf16*)(P.ws + WS_QB); const bf16* KB = (const bf16*)(P.ws + WS_KB); const bf16* VB = (const bf16*)(P.ws + WS_VB); const bf16* GB = (const bf16*)(P.ws + WS_GB); bf16* YM = (bf16*)(P.ws + WS_YM);
    const float l2g = pg8::log2g_of(h);
    qs[tid] = bfu(QB[(size_t)m * 512 + h * 64 + dv]);
    __syncthreads();
    float acc = 0.f; const int tmax = tb * 8 + 7;
    for (int s0 = 0; s0 <= tmax; s0 += 64) {
        { const int s = s0 + dv; float w = 0.f;
          if (s <= t) { const bf16* kr = KB + (size_t)(b * T + s) * 512 + h * 64; float d = 0.f;
#pragma unroll
              for (int j = 0; j < 8; ++j) { const v4u kw = *(const v4u*)(kr + 8 * j); const LAS float* q = qs + tl * 64 + 8 * j;
                  d += q[0] * bf_lo(kw.x) + q[1] * bf_hi(kw.x) + q[2] * bf_lo(kw.y) + q[3] * bf_hi(kw.y) + q[4] * bf_lo(kw.z) + q[5] * bf_hi(kw.z) + q[6] * bf_lo(kw.w) + q[7] * bf_hi(kw.w); }
              w = d * __builtin_amdgcn_exp2f(128.0f * l2g * (float)((t >> 7) - (s >> 7))); }
          wts[tl * 64 + dv] = w; }
        __syncthreads();
        const int ns = (tmax - s0 + 1) < 64 ? (tmax - s0 + 1) : 64;
        for (int sl = 0; sl < ns; ++sl) acc += wts[tl * 64 + sl] * bfu(VB[(size_t)(b * T + s0 + sl) * 512 + h * 64 + dv]);
        __syncthreads();
    }
    const float mu = wave_sum(acc) * (1.0f / 64.0f); const float dlt = acc - mu; const float var = wave_sum(dlt * dlt) * (1.0f / 64.0f);
    const float y = dlt * (1.0f / sqrtf(var + EPS)) * bfu(GB[(size_t)m * 512 + h * 64 + dv]);
    YM[(size_t)m * DM + 512 + h * 64 + dv] = (bf16)(cvtpk(y, 0.f) & 0xffffu);
    __syncthreads();
}
__device__ __forceinline__ void np2_ret_state(const Params& P, int unit, int tid) {
    const int h = unit & 7, b = unit >> 3; const int p = tid >> 3, dv0 = (tid & 7) * 8; const float l2g = pg8::log2g_of(h);
    const bf16* KB = (const bf16*)(P.ws + WS_KB); const bf16* VB = (const bf16*)(P.ws + WS_VB);
    float acc[8];
#pragma unroll
    for (int j = 0; j < 8; ++j) acc[j] = 0.f;
    for (int s = 0; s < T; ++s) { const float coef = __builtin_amdgcn_exp2f(l2g * (float)(128 * (15 - (s >> 7)) + 127)); const float kk = bfu(KB[(size_t)(b * T + s) * 512 + h * 64 + p]) * coef;
        const v4u vw = *(const v4u*)(VB + (size_t)(b * T + s) * 512 + h * 64 + dv0);
        acc[0] += kk * bf_lo(vw.x); acc[1] += kk * bf_hi(vw.x); acc[2] += kk * bf_lo(vw.y); acc[3] += kk * bf_hi(vw.y); acc[4] += kk * bf_lo(vw.z); acc[5] += kk * bf_hi(vw.z); acc[6] += kk * bf_lo(vw.w); acc[7] += kk * bf_hi(vw.w); }
    const int d = (p & 1) ? 32 + (p >> 1) : (p >> 1);
    float* o = P.out + O_RSP + ((size_t)(b * 8 + h) * 64 + d) * 64 + dv0;
    *(f32x4*)o = (f32x4){acc[0], acc[1], acc[2], acc[3]}; *(f32x4*)(o + 4) = (f32x4){acc[4], acc[5], acc[6], acc[7]};
}

__device__ __forceinline__ int block_count(int c, LAS int* red, int wave, int lane) {
#pragma unroll
    for (int o = 1; o < 64; o <<= 1) c += __shfl_xor(c, o);
    if (lane == 0) red[wave] = c; __syncthreads();
    int s = 0;
#pragma unroll
    for (int w = 0; w < NWAVES; ++w) s += red[w];
    __syncthreads(); return s;
}
__device__ __forceinline__ void p2_sample_attn(const Params& P, LAS unsigned char* lds, int unit, int tid, int wave, int lane) {
    const int b = unit >> 2, q = unit & 3, row = unit, qpos = PAST + q;
    const float* zs = (const float*)(P.ws + WS_ZS); const float* scs = (const float*)(P.ws + WS_SCS); const float* bias2 = (const float*)(P.ws + WS_BIAS);
    LAS float* vl = (LAS float*)lds;
    LAS float* lg = (LAS float*)(lds + AUX_OFF);
    LAS float* qa = lg + 2048;
    LAS int* sel = (LAS int*)(qa + 512);
    LAS int* red = sel + 256;
    LAS float* rinv = (LAS float*)(red + 16);
    LAS int* cntp = (LAS int*)(rinv + 8);
    LAS float* qi = (LAS float*)lds;
    qi[tid] = zs[(size_t)row * D_IN + C_QI + tid]; qa[tid] = zs[(size_t)row * D_IN + C_QA + tid] * 0.18033688011112042f; if (tid == 0) cntp[0] = 0;
    __syncthreads();
    unsigned key[33];
#pragma unroll
    for (int j = 0; j < 32; ++j) key[j] = fkey(scs[(size_t)row * PAST + j * 512 + tid]);
    key[32] = 0u;
    if (tid < 4 && tid <= q) { const float* kn = zs + (size_t)(b * 4 + tid) * D_IN + C_KI; float score = 0.f;
        for (int hd = 0; hd < 8; ++hd) { float d = 0.f; for (int j = 0; j < 64; ++j) d += qi[hd * 64 + j] * kn[j]; score += zs[(size_t)row * D_IN + C_WI + hd] * WSCALE * fmaxf(d, 0.f); }
        key[32] = fkey(score); }
    __syncthreads();
    unsigned ans = 0u; bool exact = false;
    for (int bit = 31; bit >= 0; --bit) { const unsigned cand = ans | (1u << bit); int c = 0;
#pragma unroll
        for (int j = 0; j < 33; ++j) c += (key[j] >= cand) ? 1 : 0;
        c = block_count(c, red, wave, lane);
        if (c >= 256) ans = cand;
        if (c == 256) { exact = true; break; } }
    int n_ge = 256;
    if (!exact) { int c = 0;
#pragma unroll
        for (int j = 0; j < 33; ++j) c += (key[j] >= ans) ? 1 : 0;
        n_ge = block_count(c, red, wave, lane); }
    const bool ties = n_ge != 256;
#pragma unroll
    for (int j = 0; j < 33; ++j) { const bool s = ties ? (key[j] > ans) : (key[j] >= ans); if (s) { const int pos = atomicAdd((int*)cntp, 1); sel[pos] = (j < 32) ? j * 512 + tid : PAST + tid; } }
    __syncthreads();
    if (ties && wave == 0) {
        int have = cntp[0];
        for (int ch = 0; ch < (PAST + 4 + 63) / 64 && have < 256; ++ch) { const int pos = ch * 64 + lane; unsigned k = 0u;
            if (pos < PAST) k = fkey(scs[(size_t)row * PAST + pos]);
            else if (pos - PAST <= q) { const float* kn = zs + (size_t)(b * 4 + pos - PAST) * D_IN + C_KI; float score = 0.f;
                for (int hd = 0; hd < 8; ++hd) { float d = 0.f; for (int j = 0; j < 64; ++j) d += zs[(size_t)row * D_IN + C_QI + hd * 64 + j] * kn[j]; score += zs[(size_t)row * D_IN + C_WI + hd] * WSCALE * fmaxf(d, 0.f); }
                k = fkey(score); }
            const bool eq = (k == ans) && (pos < PAST + 4); unsigned long long mk = __ballot(eq);
            const int before = __popcll(mk & ((1ull << lane) - 1ull));
            if (eq && have + before < 256) sel[have + before] = pos;
            have += __popcll(mk); }
    }
    __syncthreads();
    { const int k = tid >> 1, n = tid & 1, idx = sel[k]; const float* kr;
      if (idx < PAST) { const int phys = P.page_table[b * NPG + (idx >> 7)]; kr = P.cache_k + ((size_t)phys * PAGE + (idx & 127)) * 128 + n * 64; }
      else kr = zs + (size_t)(b * 4 + idx - PAST) * D_IN + C_KA + n * 64;
      f32x4 kv[16];
#pragma unroll
      for (int j = 0; j < 16; ++j) kv[j] = *(const f32x4*)(kr + 4 * j);
      const int dist = qpos - idx; const int bi = (dist < 127 ? dist : 127) * 8;
#pragma unroll
      for (int g = 0; g < 4; ++g) { const int hd = 4 * n + g; float d = 0.f;
#pragma unroll
          for (int j = 0; j < 16; ++j) { const LAS float* qq = qa + hd * 64 + 4 * j; d += qq[0] * kv[j][0] + qq[1] * kv[j][1] + qq[2] * kv[j][2] + qq[3] * kv[j][3]; }
          lg[hd * 256 + k] = d + bias2[bi + hd]; }
    }
    __syncthreads();
    { const int hd = wave; float mx = -3.0e38f; for (int k = lane; k < 256; k += 64) mx = fmaxf(mx, lg[hd * 256 + k]);
#pragma unroll
      for (int o = 1; o < 64; o <<= 1) mx = fmaxf(mx, __shfl_xor(mx, o));
      float sum = 0.f; for (int k = lane; k < 256; k += 64) { const float p = __builtin_amdgcn_exp2f(lg[hd * 256 + k] - mx); lg[hd * 256 + k] = p; sum += p; }
      sum = wave_sum(sum); if (lane == 0) rinv[hd] = 1.0f / sum; }
    { const int k = tid >> 1, n = tid & 1, idx = sel[k]; const float* vr;
      if (idx < PAST) { const int phys = P.page_table[b * NPG + (idx >> 7)]; vr = P.cache_v + ((size_t)phys * PAGE + (idx & 127)) * 128 + n * 64; }
      else vr = zs + (size_t)(b * 4 + idx - PAST) * D_IN + C_VA + n * 64;
#pragma unroll
      for (int j = 0; j < 16; ++j) *(LAS f32x4*)(vl + k * 128 + n * 64 + 4 * j) = *(const f32x4*)(vr + 4 * j);
    }
    __syncthreads();
    { const int hd = tid >> 6, d = tid & 63; float acc = 0.f;
      for (int k = 0; k < 256; ++k) acc += lg[hd * 256 + k] * vl[k * 128 + (hd >> 2) * 64 + d];
      const float o = acc * rinv[hd] * pg8::silu_f(zs[(size_t)row * D_IN + C_GA + tid]);
      ((bf16*)(P.ws + WS_YMS))[(size_t)row * DM + tid] = (bf16)(cvtpk(o, 0.f) & 0xffffu); }
    __syncthreads();
}

__device__ __forceinline__ void p2_sample_ret(const Params& P, LAS unsigned char* lds, int unit, int tid, int wave, int lane) {
    const int h = unit & 7, b = unit >> 3; const float* zs = (const float*)(P.ws + WS_ZS); const float* rope = (const float*)(P.ws + WS_ROPE);
    LAS float* qs = (LAS float*)lds; LAS float* ks = qs + 256; LAS float* vs = ks + 256; LAS float* qk = vs + 256; LAS float* part = qk + 16;
    const float l2g = pg8::log2g_of(h);
    if (tid < 256) { const int i = tid >> 6, d = tid & 63, row = b * 4 + i; const float* zr = zs + (size_t)row * D_IN; const int fi = d & 31;
        const float c = rope[((size_t)(2048 + i) * 32 + fi) * 2], s = rope[((size_t)(2048 + i) * 32 + fi) * 2 + 1];
        const float q1 = zr[C_QB + h * 64 + fi], q2 = zr[C_QB + h * 64 + 32 + fi], k1 = zr[C_KB + h * 64 + fi], k2 = zr[C_KB + h * 64 + 32 + fi];
        qs[tid] = (d < 32) ? (q1 * c - q2 * s) : (q1 * s + q2 * c); ks[tid] = 0.125f * ((d < 32) ? (k1 * c - k2 * s) : (k1 * s + k2 * c)); vs[tid] = zr[C_VB + h * 64 + d]; }
    __syncthreads();
    if (tid < 16) { const int i = tid >> 2, j = tid & 3; float d = 0.f; for (int e = 0; e < 64; ++e) d += qs[i * 64 + e] * ks[j * 64 + e]; qk[tid] = d; }
    { const int dkg = tid >> 6, dv = tid & 63; const float g4 = __builtin_amdgcn_exp2f(4.0f * l2g); float pi[4] = {0.f, 0.f, 0.f, 0.f};
      const float* s0p = P.state_ret + ((size_t)(b * 8 + h) * 64 + dkg * 8) * 64 + dv; float* sop = P.out + O_RSS + ((size_t)(b * 8 + h) * 64 + dkg * 8) * 64 + dv;
#pragma unroll
      for (int e = 0; e < 8; ++e) { const int dk = dkg * 8 + e; const float s0 = s0p[e * 64]; float sn = g4 * s0;
#pragma unroll
          for (int i = 0; i < 4; ++i) { sn += __builtin_amdgcn_exp2f((float)(3 - i) * l2g) * ks[i * 64 + dk] * vs[i * 64 + dv]; pi[i] += qs[i * 64 + dk] * s0; }
          sop[e * 64] = sn; }
#pragma unroll
      for (int i = 0; i < 4; ++i) part[(dkg * 4 + i) * 64 + dv] = pi[i]; }
    __syncthreads();
    if (tid < 256) { const int i = tid >> 6, dv = tid & 63, row = b * 4 + i; float inter = 0.f;
#pragma unroll
        for (int g = 0; g < 8; ++g) inter += part[(g * 4 + i) * 64 + dv];
        float o = inter * __builtin_amdgcn_exp2f((float)(i + 1) * l2g);
        for (int j = 0; j <= i; ++j) o += __builtin_amdgcn_exp2f((float)(i - j) * l2g) * qk[i * 4 + j] * vs[j * 64 + dv];
        const float mu = wave_sum(o) * (1.0f / 64.0f), dl = o - mu, var = wave_sum(dl * dl) * (1.0f / 64.0f);
        const float y = dl * (1.0f / sqrtf(var + EPS)) * pg8::silu_f(zs[(size_t)row * D_IN + C_GB + h * 64 + dv]);
        ((bf16*)(P.ws + WS_YMS))[(size_t)row * DM + 512 + h * 64 + dv] = (bf16)(cvtpk(y, 0.f) & 0xffffu); }
    __syncthreads();
}

__device__ __forceinline__ void p3_sample_merge(const Params& P, LAS unsigned char* lds, int row, int tid, int wave, int lane) {
    LAS float* a = (LAS float*)lds; LAS float* x1 = a + 1024; LAS float* pp = x1 + 1024; LAS float* red = pp + 256;
    const bf16* yms = (const bf16*)(P.ws + WS_YMS);
    a[tid] = bfu(yms[(size_t)row * DM + tid]); a[tid + 512] = bfu(yms[(size_t)row * DM + 512 + tid]); if (tid < 256) pp[tid] = P.p_s[(size_t)row * DPLE + tid];
    __syncthreads();
    float y0 = 0.f, y1 = 0.f;
    for (int k = 0; k < DM; ++k) { const float av = a[k]; y0 += av * P.w_out[(size_t)k * DM + tid]; y1 += av * P.w_out[(size_t)k * DM + 512 + tid]; }
    const float ssq = block_sum(y0 * y0 + y1 * y1, red, wave, lane); const float rs = 1.0f / sqrtf(ssq * (1.0f / DM) + EPS);
    const float xa = P.x_s[(size_t)row * DM + tid] + y0 * rs * P.g_post[tid], xb = P.x_s[(size_t)row * DM + 512 + tid] + y1 * rs * P.g_post[512 + tid];
    x1[tid] = xa; x1[tid + 512] = xb;
    __syncthreads();
    float g0 = 0.f, g1 = 0.f, p0 = 0.f, p1 = 0.f;
    for (int k = 0; k < DM; ++k) { const float xv = x1[k]; g0 += xv * P.w_gate[(size_t)k * DM + tid]; g1 += xv * P.w_gate[(size_t)k * DM + 512 + tid]; }
    for (int k = 0; k < DPLE; ++k) { const float pv = pp[k]; p0 += pv * P.w_up[(size_t)k * DM + tid]; p1 += pv * P.w_up[(size_t)k * DM + 512 + tid]; }
    P.out[O_YS + (size_t)row * DM + tid] = xa + p0 * pg8::sigmoid_f(g0); P.out[O_YS + (size_t)row * DM + 512 + tid] = xb + p1 * pg8::sigmoid_f(g1);
    __syncthreads();
}

#ifndef FAST_P3
#define FAST_P3 0
#endif
constexpr size_t WS_YF = 292 * MiB, WS_END2 = 356 * MiB;
__global__ void __launch_bounds__(NWAVES * 64, 2) hymba_fwd(Params P) {
    extern __shared__ __attribute__((aligned(16))) unsigned char lds_raw[];
    LAS unsigned char* lds = (LAS unsigned char*)lds_raw;
    const int wave = __builtin_amdgcn_readfirstlane(threadIdx.x >> 6);
#define LANE_TID const int lane = lane_id(), tid = wave * 64 + lane
    const int G = gridDim.x, bx = blockIdx.x; const int vcu = (G % 8 == 0) ? (bx % 8) * (G / 8) + bx / 8 : bx;
    gu32* ctl = (gu32*)(P.ws + WS_CTL);
    volatile LAS unsigned* MISC = (volatile LAS unsigned*)(lds + LDSCTL_OFF);
    { LANE_TID; for (int u = tid; u < (LDS_BYTES - LDSCTL_OFF) / 4; u += NWAVES * 64) ((LAS unsigned*)(lds + LDSCTL_OFF))[u] = 0u; }
    __syncthreads();
    XcdBarrier bar = xcd_barrier_post((unsigned*)(ctl + CW_BAR), MISC + 8, wave == 0 && lane_id() == 0);
#define GRID_BAR() xcd_barrier(bar, wave == 0 && lane_id() == 0)
    const int lo = P.ph_lo, hi = P.ph_hi;
#define IN(k) (lo <= (k) && (k) < hi)
#define BOTH(k) (IN(k) && IN((k) + 1))

    if (IN(0)) { LANE_TID; p0_prologue(P, lds, vcu, G, wave, lane, tid); if (BOTH(0)) GRID_BAR(); }

    if (IN(1)) {
        if (vcu < SB * 8) p1_sample_index(P, vcu, wave, lane_id());
        {
            pg8::Gemm g{(const pg8::bf16_t*)(P.ws + WS_XB), (const pg8::bf16_t*)(P.ws + WS_WIN), M, NPAD, DM}; pg8::StaticOrder S; S.init(M, NPAD, G, bx);
            pg8::EpiInProj E{P.ws, P.out};
            pg8::gemm_phase<pg8::EpiInProj, pg8::StaticOrder, true, true, DM>(lds, g, S, E, wave, lane_id());
        }
        {
            pg8::Gemm g{(const pg8::bf16_t*)(P.ws + WS_PB), (const pg8::bf16_t*)(P.ws + WS_WUP), M, DM, DPLE}; pg8::StaticOrder S; S.init(M, DM, G, bx);
            pg8::EpiPlain E{(pg8::bf16_t*)(P.ws + WS_PLE), DM};
            pg8::gemm_phase<pg8::EpiPlain, pg8::StaticOrder, true, true, DPLE>(lds, g, S, E, wave, lane_id());
        }
        if (BOTH(1)) GRID_BAR();
    }

    if (IN(2)) {
        LANE_TID; __syncthreads();
        for (int u = vcu; u < SB * SQ; u += G) p2_sample_attn(P, lds, u, tid, wave, lane);
        for (int u = vcu; u < SB * 8; u += G) p2_sample_ret(P, lds, u, tid, wave, lane);
        for (int u = vcu; u < NB * 8; u += G) np2_ret_state(P, u, tid);
        for (int u = vcu; u < M; u += G) np2_dsa_query(P, lds, u, tid, wave, lane);
        for (int u = vcu; u < NB * 8 * 256; u += G) np2_ret_block(P, lds, u, tid, wave, lane);
        if (BOTH(2)) GRID_BAR();
    }

    if (IN(3)) {
        __syncthreads();
        { LANE_TID; for (int u = vcu; u < MS; u += G) p3_sample_merge(P, lds, u, tid, wave, lane); }
        __syncthreads();
        {
            pg8::Gemm g{(const pg8::bf16_t*)(P.ws + WS_YM), (const pg8::bf16_t*)(P.ws + WS_WOUT), M, DM, DM}; pg8::StaticOrder S; S.init(M, DM, G, bx);
            pg8::EpiF32 E{(float*)(P.ws + WS_YF), DM};
            pg8::gemm_phase<pg8::EpiF32, pg8::StaticOrder, true, true, DM>(lds, g, S, E, wave, lane_id());
        }
        if (BOTH(3)) GRID_BAR();
    }
    if (IN(4)) {
        LANE_TID;
        const int gw = vcu * NWAVES + wave, NGW = G * NWAVES; const float* yf = (const float*)(P.ws + WS_YF); bf16* x1b = (bf16*)(P.ws + WS_X1B);
        for (int m = gw; m < M; m += NGW) {
            f32x4 v[4]; float s = 0.f;
#pragma unroll
            for (int j = 0; j < 4; ++j) { v[j] = *((const f32x4*)(yf + (size_t)m * DM) + lane + 64 * j); s += (v[j].x * v[j].x + v[j].y * v[j].y) + (v[j].z * v[j].z + v[j].w * v[j].w); }
            s = wave_sum(s); const float rs = 1.0f / sqrtf(s * (1.0f / DM) + EPS);
#pragma unroll
            for (int j = 0; j < 4; ++j) { const f32x4 xv = *((const f32x4*)(P.x_p + (size_t)m * DM) + lane + 64 * j), gp = *((const f32x4*)P.g_post + lane + 64 * j); const f32x4 o = xv + v[j] * rs * gp;
                *((f32x4*)(P.out + O_YP + (size_t)m * DM) + lane + 64 * j) = o; u32x2v w; w.x = cvtpk(o.x, o.y); w.y = cvtpk(o.z, o.w); *((u32x2v*)(x1b + (size_t)m * DM) + lane + 64 * j) = w; }
        }
        if (BOTH(4)) GRID_BAR();
    }
    if (IN(5)) {
        pg8::Gemm g{(const pg8::bf16_t*)(P.ws + WS_X1B), (const pg8::bf16_t*)(P.ws + WS_WGATE), M, DM, DM}; pg8::StaticOrder S; S.init(M, DM, G, bx);
        pg8::EpiGate E{P.out + O_YP, (const pg8::bf16_t*)(P.ws + WS_PLE), DM};
        pg8::gemm_phase<pg8::EpiGate, pg8::StaticOrder, true, true, DM>(lds, g, S, E, wave, lane_id());
    }
#undef IN
#undef BOTH
}

#ifndef MK_N_LAUNCHES
#define MK_N_LAUNCHES 1
#endif
constexpr int N_PHASES = 6;
extern "C" void kernel_launch(void* const* d_in, const int* in_sizes, int n_in, void* d_out, int out_size, void* d_ws, size_t ws_size, hipStream_t stream) {
    static int grid = 0;
    if (grid == 0) {
        if (n_in != 16 || (size_t)out_size != O_END || ws_size < WS_END2) { fprintf(stderr, "kernel_launch: unexpected shapes (n_in %d out %d ws %zu); nothing launched\n", n_in, out_size, ws_size); grid = -1; return; }
        int dev = 0, cus = 0;
        if (hipGetDevice(&dev) != hipSuccess || hipDeviceGetAttribute(&cus, hipDeviceAttributeMultiprocessorCount, dev) != hipSuccess) { grid = -1; return; }
        if (hipFuncSetAttribute((const void*)hymba_fwd, hipFuncAttributeMaxDynamicSharedMemorySize, LDS_BYTES) != hipSuccess) { fprintf(stderr, "kernel_launch: hipFuncSetAttribute failed\n"); grid = -1; return; }
        (void)hipGetLastError();
        grid = cus;
        if (grid != 256) fprintf(stderr, "kernel_launch: %d CUs (built for 256)\n", grid);
    }
    if (grid < 0) return;
    if (hipMemsetAsync((char*)d_ws + WS_CTL, 0, CTL_ZERO_BYTES, stream) != hipSuccess) return;
    Params a{};
    a.x_p = (const float*)d_in[0]; a.x_s = (const float*)d_in[1]; a.cache_k = (const float*)d_in[2]; a.cache_v = (const float*)d_in[3]; a.cache_kidx = (const float*)d_in[4];
    a.state_ret = (const float*)d_in[5]; a.page_table = (const int*)d_in[6]; a.p_p = (const float*)d_in[7]; a.p_s = (const float*)d_in[8]; a.rel_bias = (const float*)d_in[9];
    a.w_in = (const float*)d_in[10]; a.w_out = (const float*)d_in[11]; a.g_pre = (const float*)d_in[12]; a.g_post = (const float*)d_in[13]; a.w_up = (const float*)d_in[14]; a.w_gate = (const float*)d_in[15];
    a.out = (float*)d_out; a.ws = (unsigned char*)d_ws;
    if (MK_N_LAUNCHES == 1) { a.ph_lo = 0; a.ph_hi = N_PHASES; hipLaunchKernelGGL(hymba_fwd, dim3(grid), dim3(NWAVES * 64), LDS_BYTES, stream, a); }
    else for (int p = 0; p < N_PHASES; ++p) { a.ph_lo = p; a.ph_hi = p + 1; hipLaunchKernelGGL(hymba_fwd, dim3(grid), dim3(NWAVES * 64), LDS_BYTES, stream, a); }
}
```

```cpp
#include <hip/hip_runtime.h>
#include <cstdio>
#include <cstdint>

constexpr int NWAVES = 8;
constexpr int DM = 1024, NB = 8, T = 2048, M = NB * T, SB = 32, SQ = 4, MS = SB * SQ, PAST = 16384, PAGE = 128, NPG = PAST / PAGE;
constexpr int D_IN = 3912, NPAD = 4096, DPLE = 256;
constexpr int C_QA = 0, C_KA = 512, C_VA = 640, C_QI = 768, C_KI = 1280, C_WI = 1344, C_GA = 1352, C_QB = 1864, C_KB = 2376, C_VB = 2888, C_GB = 3400;
constexpr float EPS = 1e-6f;
constexpr float LOG2E = 1.4426950408889634f;
constexpr float WSCALE = 0.04419417382415922f;
constexpr size_t O_YP = 0, O_YS = 16777216, O_KP = 16908288, O_VP = 19005440, O_KIP = 21102592, O_RSP = 22151168, O_KS = 22413312, O_VS = 22429696, O_KIS = 22446080, O_RSS = 22454272, O_END = 23502848;
constexpr size_t MiB = 1u << 20;
constexpr size_t WS_CTL = 0, CTL_ZERO_BYTES = 1 * MiB;
constexpr size_t WS_WIN = 2 * MiB, WS_WOUT = 10 * MiB, WS_WGATE = 12 * MiB, WS_WUP = 14 * MiB;
constexpr size_t WS_RSTD = 15 * MiB, WS_ROPE = 15 * MiB + 256 * 1024, WS_BIAS = 15 * MiB + 832 * 1024, WS_XCH = 16 * MiB, WS_ZS = 17 * MiB, WS_SCS = 20 * MiB, WS_YS = 28 * MiB, WS_YMS = 29 * MiB;
constexpr size_t WS_XB = 32 * MiB, WS_PB = 64 * MiB, WS_QA = 72 * MiB, WS_KA = 88 * MiB, WS_VA = 92 * MiB, WS_QI = 96 * MiB, WS_KI = 112 * MiB, WS_WI = 114 * MiB;
constexpr size_t WS_GA = 116 * MiB, WS_QB = 132 * MiB, WS_KB = 148 * MiB, WS_VB = 164 * MiB, WS_GB = 180 * MiB, WS_PLE = 196 * MiB, WS_YM = 228 * MiB, WS_X1B = 260 * MiB, WS_END = 292 * MiB;
static_assert(WS_ROPE + (size_t)2052 * 32 * 2 * 4 <= WS_BIAS && WS_BIAS + 128 * 8 * 4 <= WS_XCH && WS_ZS + (size_t)MS * D_IN * 4 <= WS_SCS, "ws map");
constexpr int CW_TMO = 0, CW_BAR = 4096, CW_SEAM = 16384, CW_QUEUE = 24576, CW_SSQ = 32768;
constexpr int RING_BYTES = 131072, AUX_OFF = RING_BYTES, AUX_BYTES = 15360, LDSCTL_OFF = AUX_OFF + AUX_BYTES, LDS_BYTES = 147456;
static_assert(LDSCTL_OFF + 256 <= LDS_BYTES, "LDS map");

namespace pg8 {
#define PG8_LAS __attribute__((address_space(3)))
typedef unsigned short bf16_t;
typedef short bf16x8 __attribute__((ext_vector_type(8)));
typedef float f32x4 __attribute__((ext_vector_type(4)));
typedef unsigned u32x4 __attribute__((ext_vector_type(4)));
constexpr int BM = 256, BK = 64, HALF = 128, HTB = HALF * BK * 2  , STAGE_BYTES = 8 * HTB, NXCD = 8, WGM = 8;

__host__ __device__ __forceinline__ int lds_byte(int r, int c) { const int st = (r >> 4) * 2 + (c >> 5), rr = r & 15, cc = c & 31, ob = rr * 64 + cc * 2; return st * 1024 + (ob ^ (((ob >> 9) & 1) << 5)); }
__host__ __device__ __forceinline__ void stage_rc(int b, int& R, int& C) { const int st = b / 1024, sb = b % 1024, swz = sb ^ (((sb >> 9) & 1) << 5); R = (st >> 1) * 16 + swz / 64; C = (st & 1) * 32 + (swz % 64) / 2; }
__host__ __device__ __forceinline__ int perm32(int rho) { const int n = rho >> 4, i = rho & 15; return 8 * (i >> 2) + 4 * n + (i & 3); }

struct Unit { int pm, pn; };
struct Gemm { const bf16_t* A; const bf16_t* Bt; int M, N, K; };

struct StaticOrder {
    int nM, nN, nwg, G, c;
    __host__ __device__ void init(int M, int N, int G_, int c_) { nM = M / BM; nN = N / BM; nwg = nM * nN; G = G_; c = c_; }
    __host__ __device__ bool next(int i, Unit& u) const {
        const long L = (long)i * G + c; if (L >= nwg) return false;
        int wgid = (int)L; { const int q = nwg / NXCD, r = nwg % NXCD, xcd = wgid % NXCD, off = wgid / NXCD; wgid = (xcd < r ? xcd * (q + 1) : r * (q + 1) + (xcd - r) * q) + off; }
        const int nig = WGM * nN, gid = wgid / nig, fm = gid * WGM, gsz = (nM - fm) < WGM ? (nM - fm) : WGM;
        u.pm = fm + ((wgid % nig) % gsz); u.pn = (wgid % nig) / gsz; return true;
    }
    __device__ __forceinline__ void a_ready(const Unit&) const {}
    __device__ __forceinline__ void done(const Unit&) const {}
};


typedef float f32x2 __attribute__((ext_vector_type(2)));
typedef __bf16 bf16x2_n __attribute__((ext_vector_type(2)));
typedef unsigned u32x2 __attribute__((ext_vector_type(2)));
__device__ __forceinline__ unsigned cvt_pk_bf16(float lo, float hi) { unsigned r; asm volatile("v_cvt_pk_bf16_f32 %0, %1, %2" : "=v"(r) : "v"(lo), "v"(hi)); return r; }
__device__ __forceinline__ unsigned cvt_pk_bf16_c(float lo, float hi) { f32x2 v = {lo, hi}; bf16x2_n b = __builtin_convertvector(v, bf16x2_n); return __builtin_bit_cast(unsigned, b); }
__device__ __forceinline__ void store8_bf16(bf16_t* p, f32x4 v0, f32x4 v1) { u32x4 w; w.x = cvt_pk_bf16(v0[0], v0[1]); w.y = cvt_pk_bf16(v0[2], v0[3]); w.z = cvt_pk_bf16(v1[0], v1[1]); w.w = cvt_pk_bf16(v1[2], v1[3]); *(u32x4*)p = w; }
__device__ __forceinline__ float silu_f(float x) { return x * __builtin_amdgcn_rcpf(1.0f + __builtin_amdgcn_exp2f(-1.4426950408889634f * x)); }
__device__ __forceinline__ float sigmoid_f(float x) { return __builtin_amdgcn_rcpf(1.0f + __builtin_amdgcn_exp2f(-1.4426950408889634f * x)); }
__device__ __forceinline__ f32x4 silu4(f32x4 v) { f32x4 o; o[0] = silu_f(v[0]); o[1] = silu_f(v[1]); o[2] = silu_f(v[2]); o[3] = silu_f(v[3]); return o; }
__device__ __forceinline__ float log2g_of(int h) { return __builtin_amdgcn_logf(1.0f - __builtin_amdgcn_exp2f((float)(-5 - h))); }

struct EpiPlain {
    static constexpr bool PERM = true, AFTER_DRAIN = false;
    bf16_t* O; int ldc;
    __device__ __forceinline__ void operator()(const f32x4 (&acc)[2][2][4][2], const Unit& u, int wr, int wc, int fr, int fq) const {
        asm volatile("" : "+v"(fr), "+v"(fq));
        const int row0 = u.pm * BM + wr * 64 + fr, col0 = u.pn * BM + wc * 32 + 8 * fq;
#pragma unroll
        for (int ai = 0; ai < 2; ++ai)
#pragma unroll
            for (int m = 0; m < 4; ++m) { bf16_t* rowp = O + (size_t)(row0 + ai * HALF + m * 16) * ldc + col0;
#pragma unroll
                for (int bj = 0; bj < 2; ++bj) store8_bf16(rowp + bj * HALF, acc[ai][bj][m][0], acc[ai][bj][m][1]); }
    }
};

struct EpiInProj {
    static constexpr bool PERM = true, AFTER_DRAIN = false;
    unsigned char* ws; float* outp;
    __device__ __forceinline__ void operator()(const f32x4 (&acc)[2][2][4][2], const Unit& u, int wr, int wc, int fr, int fq) const {
        asm volatile("" : "+v"(fr), "+v"(fq));
        const float* rstd = (const float*)(ws + WS_RSTD); const float* rope = (const float*)(ws + WS_ROPE);
        bf16_t *QA = (bf16_t*)(ws + WS_QA), *KA = (bf16_t*)(ws + WS_KA), *VA = (bf16_t*)(ws + WS_VA), *QI = (bf16_t*)(ws + WS_QI), *KI = (bf16_t*)(ws + WS_KI), *GA = (bf16_t*)(ws + WS_GA);
        bf16_t *QB = (bf16_t*)(ws + WS_QB), *KB = (bf16_t*)(ws + WS_KB), *VB = (bf16_t*)(ws + WS_VB), *GB = (bf16_t*)(ws + WS_GB); float* WI = (float*)(ws + WS_WI);
        float *oK = outp + O_KP, *oV = outp + O_VP, *oKI = outp + O_KIP;
        const int row0 = u.pm * BM + wr * 64 + fr, cb = wc * 32 + 8 * fq, pn = u.pn;
#pragma unroll
        for (int ai = 0; ai < 2; ++ai)
#pragma unroll
            for (int m = 0; m < 4; ++m) {
                const int row = row0 + ai * HALF + m * 16; const float rs = rstd[row]; const int t = row & 2047;
#pragma unroll
                for (int bj = 0; bj < 2; ++bj) {
                    f32x4 v0 = acc[ai][bj][m][0] * rs, v1 = acc[ai][bj][m][1] * rs; const int c = bj * HALF + cb;
                    if (pn < 2) { const float C2 = 0.18033688011112042f; store8_bf16(QA + (size_t)row * 512 + pn * 256 + c, v0 * C2, v1 * C2); }
                    else if (pn == 2) { float* of = (bj ? oV : oK) + (size_t)row * 128 + cb; *(f32x4*)of = v0; *(f32x4*)(of + 4) = v1; store8_bf16((bj ? VA : KA) + (size_t)row * 128 + cb, v0, v1); }
                    else if (pn < 5) store8_bf16(QI + (size_t)row * 512 + (pn - 3) * 256 + c, v0, v1);
                    else if (pn == 5) {
                        if (bj == 0) {
                            if (cb < 64) { float* of = oKI + (size_t)row * 64 + cb; *(f32x4*)of = v0; *(f32x4*)(of + 4) = v1; store8_bf16(KI + (size_t)row * 64 + cb, v0, v1); }
                            else if (cb == 64) { const float WS = 0.04419417382415922f; float* of = WI + (size_t)row * 8; *(f32x4*)of = v0 * WS; *(f32x4*)(of + 4) = v1 * WS; }
                        }
                    }
                    else if (pn < 8) store8_bf16(GA + (size_t)row * 512 + (pn - 6) * 256 + c, silu4(v0), silu4(v1));
                    else if (pn < 12) {
                        const int f = ((pn & 1) ? 256 : 0) + c, hh = f >> 6, i0 = (f & 63) >> 1;
                        const f32x4 cs0 = *(const f32x4*)(rope + ((size_t)t * 32 + i0) * 2), cs1 = *(const f32x4*)(rope + ((size_t)t * 32 + i0) * 2 + 4);
                        const float e = (float)(t & 127) * log2g_of(hh);
                        const float sc = (pn < 10) ? __builtin_amdgcn_exp2f(e) : 0.125f * __builtin_amdgcn_exp2f(-e);
                        f32x4 o0, o1;
                        o0[0] = (v0[0] * cs0[0] - v0[1] * cs0[1]) * sc; o0[1] = (v0[0] * cs0[1] + v0[1] * cs0[0]) * sc;
                        o0[2] = (v0[2] * cs0[2] - v0[3] * cs0[3]) * sc; o0[3] = (v0[2] * cs0[3] + v0[3] * cs0[2]) * sc;
                        o1[0] = (v1[0] * cs1[0] - v1[1] * cs1[1]) * sc; o1[1] = (v1[0] * cs1[1] + v1[1] * cs1[0]) * sc;
                        o1[2] = (v1[2] * cs1[2] - v1[3] * cs1[3]) * sc; o1[3] = (v1[2] * cs1[3] + v1[3] * cs1[2]) * sc;
                        store8_bf16(((pn < 10) ? QB : KB) + (size_t)row * 512 + f, o0, o1);
                    }
                    else if (pn < 14) store8_bf16(VB + (size_t)row * 512 + (pn - 12) * 256 + c, v0, v1);
                    else store8_bf16(GB + (size_t)row * 512 + (pn - 14) * 256 + c, silu4(v0), silu4(v1));
                }
                asm volatile("" ::: "memory");
            }
    }
};

struct EpiRmsRes {
    static constexpr bool PERM = false, AFTER_DRAIN = true;
    const float* base; const float* gpost; float* out; bf16_t* xb; int ldc;
    unsigned* xbuf;
    unsigned* cnt;
    unsigned* tmo;
    float eps;
    __device__ __forceinline__ void fused(f32x4 (&acc)[2][2][4][2], const Unit& u, int wr, int wc, int fr, int fq, PG8_LAS unsigned char* lds, int wid, int lane) const {
        asm volatile("" : "+v"(fr), "+v"(fq));
        PG8_LAS float* P = (PG8_LAS float*)lds;
        PG8_LAS float* S = (PG8_LAS float*)(lds + 4096);
        PG8_LAS unsigned* flag = (PG8_LAS unsigned*)(lds + 4096 + 1024);
#pragma unroll
        for (int ai = 0; ai < 2; ++ai)
#pragma unroll
            for (int m = 0; m < 4; ++m) {
                float s = 0.f;
#pragma unroll
                for (int bj = 0; bj < 2; ++bj)
#pragma unroll
                    for (int n = 0; n < 2; ++n) { const f32x4 x = acc[ai][bj][m][n]; s += (x[0] * x[0] + x[1] * x[1]) + (x[2] * x[2] + x[3] * x[3]); }
                s += __shfl_xor(s, 16); s += __shfl_xor(s, 32);
                if (fq == 0) P[(ai * HALF + wr * 64 + m * 16 + fr) * 4 + wc] = s;
            }
        asm volatile("s_waitcnt lgkmcnt(0)" ::: "memory"); __builtin_amdgcn_s_barrier(); asm volatile("" ::: "memory");
        const int row = wid * 32 + (lane & 31);
        if (lane < 32) {
            const float tot = (P[row * 4 + 0] + P[row * 4 + 1]) + (P[row * 4 + 2] + P[row * 4 + 3]);
            unsigned long long* slot = (unsigned long long*)xbuf + ((size_t)(u.pm * BM + row) * 4 + u.pn);
            __hip_atomic_store(slot, (unsigned long long)__float_as_uint(tot), __ATOMIC_RELAXED, __HIP_MEMORY_SCOPE_AGENT);
        }
        asm volatile("s_waitcnt vmcnt(0)" ::: "memory");
        if (lane == 0) __hip_atomic_fetch_add(cnt + 64 * u.pm, 1u, __ATOMIC_RELAXED, __HIP_MEMORY_SCOPE_AGENT);
        if (wid == 0) {
            bool dead = false; const unsigned long long t0 = __builtin_amdgcn_s_memrealtime();
            for (;;) {
                if ((unsigned)__builtin_amdgcn_readfirstlane(__hip_atomic_load(cnt + 64 * u.pm, __ATOMIC_RELAXED, __HIP_MEMORY_SCOPE_AGENT)) >= 32u) break;
                if (__builtin_amdgcn_s_memrealtime() - t0 > 2000000ull) { if (lane == 0) __hip_atomic_store(tmo, 1u, __ATOMIC_RELAXED, __HIP_MEMORY_SCOPE_AGENT); dead = true; break; }
                __builtin_amdgcn_s_sleep(2);
            }
            __builtin_amdgcn_fence(__ATOMIC_ACQUIRE, "agent");
            if (lane == 0) flag[0] = dead ? 1u : 0u;
        }
        asm volatile("s_waitcnt vmcnt(0) lgkmcnt(0)" ::: "memory"); __builtin_amdgcn_s_barrier(); asm volatile("" ::: "memory");
        const bool bad = flag[0] != 0u;
        if (lane < 32) {
            const unsigned long long* slot = (const unsigned long long*)xbuf + (size_t)(u.pm * BM + row) * 4; float q = 0.f;
#pragma unroll
            for (int t = 0; t < 4; ++t) { const unsigned long long w = __hip_atomic_load(slot + t, __ATOMIC_RELAXED, __HIP_MEMORY_SCOPE_AGENT); q += __uint_as_float((unsigned)w); }
            S[row] = 1.0f / sqrtf(q * (1.0f / 1024.0f) + eps);
        }
        asm volatile("s_waitcnt lgkmcnt(0)" ::: "memory"); __builtin_amdgcn_s_barrier(); asm volatile("" ::: "memory");
        const float qnan = __builtin_nanf("");
        const int col0 = u.pn * BM + wc * 32 + 4 * fq;
#pragma unroll
        for (int ai = 0; ai < 2; ++ai)
#pragma unroll
            for (int m = 0; m < 4; ++m) { const int r = ai * HALF + wr * 64 + m * 16 + fr; const float sr = S[r]; const size_t off = (size_t)(u.pm * BM + r) * ldc + col0;
#pragma unroll
                for (int bj = 0; bj < 2; ++bj)
#pragma unroll
                    for (int n = 0; n < 2; ++n) { const f32x4 bs = *(const f32x4*)(base + off + bj * HALF + n * 16); const f32x4 gp = *(const f32x4*)(gpost + col0 + bj * HALF + n * 16);
                        f32x4 o = bs + acc[ai][bj][m][n] * sr * gp; if (bad) o = (f32x4){qnan, qnan, qnan, qnan};
                        *(f32x4*)(out + off + bj * HALF + n * 16) = o;
                        u32x2 w; w.x = cvt_pk_bf16(o[0], o[1]); w.y = cvt_pk_bf16(o[2], o[3]); *(u32x2*)(xb + off + bj * HALF + n * 16) = w; }
                if (m & 1) asm volatile("" ::: "memory"); }
    }
};

struct EpiGate {
    static constexpr bool PERM = false, AFTER_DRAIN = false;
    float* io; const bf16_t* ple; int ldc;
    __device__ __forceinline__ void operator()(const f32x4 (&acc)[2][2][4][2], const Unit& u, int wr, int wc, int fr, int fq) const {
        asm volatile("" : "+v"(fr), "+v"(fq));
        const int col0 = u.pn * BM + wc * 32 + 4 * fq;
#pragma unroll
        for (int ai = 0; ai < 2; ++ai)
#pragma unroll
            for (int m = 0; m < 4; ++m) { const size_t off = (size_t)(u.pm * BM + ai * HALF + wr * 64 + m * 16 + fr) * ldc + col0;
#pragma unroll
                for (int bj = 0; bj < 2; ++bj)
#pragma unroll
                    for (int n = 0; n < 2; ++n) { const size_t o2 = off + bj * HALF + n * 16; const f32x4 x1 = *(const f32x4*)(io + o2); const u32x2 pw = *(const u32x2*)(ple + o2); const f32x4 a = acc[ai][bj][m][n];
                        f32x4 o; o[0] = x1[0] + __uint_as_float(pw.x << 16) * sigmoid_f(a[0]); o[1] = x1[1] + __uint_as_float(pw.x & 0xffff0000u) * sigmoid_f(a[1]);
                        o[2] = x1[2] + __uint_as_float(pw.y << 16) * sigmoid_f(a[2]); o[3] = x1[3] + __uint_as_float(pw.y & 0xffff0000u) * sigmoid_f(a[3]);
                        *(f32x4*)(io + o2) = o; }
                if (m & 1) asm volatile("" ::: "memory"); }
    }
};

struct EpiF32 {
    static constexpr bool PERM = false, AFTER_DRAIN = false;
    float* O; int ldc;
    __device__ __forceinline__ void operator()(const f32x4 (&acc)[2][2][4][2], const Unit& u, int wr, int wc, int fr, int fq) const {
        asm volatile("" : "+v"(fr), "+v"(fq));
        const int col0 = u.pn * BM + wc * 32 + 4 * fq;
#pragma unroll
        for (int ai = 0; ai < 2; ++ai)
#pragma unroll
            for (int m = 0; m < 4; ++m) { const size_t off = (size_t)(u.pm * BM + ai * HALF + wr * 64 + m * 16 + fr) * ldc + col0;
#pragma unroll
                for (int bj = 0; bj < 2; ++bj)
#pragma unroll
                    for (int n = 0; n < 2; ++n) *(f32x4*)(O + off + bj * HALF + n * 16) = acc[ai][bj][m][n];
                asm volatile("" ::: "memory"); }
    }
};
template <class Epi, class Sched, bool ALIGN_EPI = false, bool SP2 = false, int KC = 0>
__device__ __forceinline__ void gemm_phase(PG8_LAS unsigned char* lds, const Gemm g, const Sched& S, const Epi& E, const int wid, const int lane) {
    const int tid = wid * 64 + lane, wr = wid >> 2, wc = wid & 3, fr = lane & 15, fq = lane >> 4;
    const int K = KC ? KC : g.K, nt = K / BK;
    unsigned voffA[2], voffB[2];
#pragma unroll
    for (int i = 0; i < 2; ++i) { int R, C; stage_rc(tid * 16 + i * 8192, R, C); const int Rb = Epi::PERM ? ((R & ~31) + perm32(R & 31)) : R;
        voffA[i] = (unsigned)(R * K + C) * 2u; voffB[i] = (unsigned)(Rb * K + C) * 2u; }
    const size_t kstep = (size_t)(BK * 2);
    const size_t hstep = (size_t)HALF * K * 2;
    const size_t tstep = 2 * hstep;
    const unsigned ldsw = (unsigned)wid * 1024u;
    const int aoff = lds_byte(wr * 64 + fr, fq * 8), boff = lds_byte(wc * 32 + fr, fq * 8);
#define PG8_SA(b, h) (((b) * 2 + (h)) * HTB)
#define PG8_SB(b, h) ((4 + (b) * 2 + (h)) * HTB)
#define PG8_STAGE(bufoff, gbase, voff) do { _Pragma("unroll") for (int _i = 0; _i < 2; ++_i) \
        __builtin_amdgcn_global_load_lds((const unsigned*)((const char*)(gbase) + (voff)[_i]), (PG8_LAS unsigned*)(lds + (bufoff) + ldsw + _i * 8192), 16, 0, 0); } while (0)
#define PG8_LDA(dst, b, h) do { _Pragma("unroll") for (int m = 0; m < 4; ++m) _Pragma("unroll") for (int k = 0; k < 2; ++k) dst[m][k] = *(const PG8_LAS bf16x8*)(lds + PG8_SA(b, h) + aoff + m * 2048 + k * 1024); } while (0)
#define PG8_LDB(dst, b, h) do { _Pragma("unroll") for (int n = 0; n < 2; ++n) _Pragma("unroll") for (int k = 0; k < 2; ++k) dst[n][k] = *(const PG8_LAS bf16x8*)(lds + PG8_SB(b, h) + boff + n * 2048 + k * 1024); } while (0)
#define PG8_MMA(ai, bj, At, Bt) do { __builtin_amdgcn_s_setprio(1); _Pragma("unroll") for (int m = 0; m < 4; ++m) _Pragma("unroll") for (int n = 0; n < 2; ++n) _Pragma("unroll") for (int k = 0; k < 2; ++k) \
        acc[ai][bj][m][n] = __builtin_amdgcn_mfma_f32_16x16x32_bf16(Bt[n][k], At[m][k], acc[ai][bj][m][n], 0, 0, 0); __builtin_amdgcn_s_setprio(0); } while (0)
#define PG8_WAIT_V(n) asm volatile("s_waitcnt vmcnt(" #n ")" ::: "memory")
#define PG8_WAIT_L(n) asm volatile("s_waitcnt lgkmcnt(" #n ")" ::: "memory")
#define PG8_BAR __builtin_amdgcn_s_barrier()
#define PG8_SCHED __builtin_amdgcn_sched_barrier(0)
    Unit cur, nxt; int ui = 0;
    if (!S.next(0, cur)) return;
    f32x4 acc[2][2][4][2];
#pragma unroll
    for (int a = 0; a < 2; ++a)
#pragma unroll
        for (int b = 0; b < 2; ++b)
#pragma unroll
            for (int m = 0; m < 4; ++m)
#pragma unroll
                for (int n = 0; n < 2; ++n) acc[a][b][m][n] = (f32x4){0.f, 0.f, 0.f, 0.f};
    bf16x8 At[4][2], B0[2][2], B1[2][2];
    const char* cA = (const char*)g.A + (size_t)cur.pm * tstep; const char* cB = (const char*)g.Bt + (size_t)cur.pn * tstep;
    S.a_ready(cur);
    if constexpr (SP2) {
        PG8_STAGE(PG8_SB(0, 0), cB, voffB); PG8_STAGE(PG8_SB(0, 1), cB + hstep, voffB); PG8_STAGE(PG8_SA(0, 0), cA, voffA); PG8_STAGE(PG8_SA(0, 1), cA + hstep, voffA);
        if (wr == 1) PG8_BAR;
        PG8_WAIT_V(2); PG8_BAR;
        PG8_STAGE(PG8_SB(1, 0), cB + kstep, voffB); PG8_STAGE(PG8_SA(1, 0), cA + kstep, voffA); PG8_STAGE(PG8_SB(1, 1), cB + hstep + kstep, voffB);
        PG8_WAIT_V(6); PG8_BAR;
    } else {
        PG8_STAGE(PG8_SB(0, 0), cB, voffB); PG8_STAGE(PG8_SA(0, 0), cA, voffA); PG8_STAGE(PG8_SB(0, 1), cB + hstep, voffB); PG8_STAGE(PG8_SA(0, 1), cA + hstep, voffA);
        if (wr == 1) PG8_BAR;
        PG8_WAIT_V(4); PG8_BAR;
        PG8_STAGE(PG8_SB(1, 0), cB + kstep, voffB); PG8_STAGE(PG8_SA(1, 0), cA + kstep, voffA); PG8_STAGE(PG8_SB(1, 1), cB + hstep + kstep, voffB);
        PG8_WAIT_V(6); PG8_BAR;
    }
    for (;;) {
        const bool has_next = S.next(ui + 1, nxt);
        const char* nA = has_next ? (const char*)g.A + (size_t)nxt.pm * tstep : cA; const char* nB = has_next ? (const char*)g.Bt + (size_t)nxt.pn * tstep : cB;
        for (int t = 0; t < nt; t += 2) {
            const bool last = (t == nt - 2);
            const char* a1 = cA + (size_t)(t + 1) * kstep;
            const char* a2 = last ? nA : cA + (size_t)(t + 2) * kstep; const char* b2 = last ? nB : cB + (size_t)(t + 2) * kstep;
            const char* a3 = a2 + kstep; const char* b3 = b2 + kstep;
            if (last && has_next) S.a_ready(nxt);
            if constexpr (SP2) {
            PG8_LDB(B0, 0, 0); PG8_LDB(B1, 0, 1); PG8_SCHED; PG8_LDA(At, 0, 0); PG8_STAGE(PG8_SA(1, 1), a1 + hstep, voffA);
            PG8_WAIT_V(8); PG8_WAIT_L(0); PG8_BAR; PG8_MMA(0, 0, At, B0); PG8_MMA(0, 1, At, B1); PG8_BAR; PG8_SCHED;
            PG8_LDA(At, 0, 1); PG8_STAGE(PG8_SB(0, 0), b2, voffB); PG8_STAGE(PG8_SB(0, 1), b2 + hstep, voffB); PG8_STAGE(PG8_SA(0, 0), a2, voffA);
            PG8_WAIT_V(8); PG8_WAIT_L(0); PG8_BAR; PG8_MMA(1, 0, At, B0); PG8_MMA(1, 1, At, B1); PG8_BAR; PG8_SCHED;
            PG8_LDB(B0, 1, 0); PG8_LDB(B1, 1, 1); PG8_SCHED; PG8_LDA(At, 1, 0); PG8_STAGE(PG8_SA(0, 1), a2 + hstep, voffA);
            PG8_WAIT_V(8); PG8_WAIT_L(0); PG8_BAR; PG8_MMA(0, 0, At, B0); PG8_MMA(0, 1, At, B1); PG8_BAR; PG8_SCHED;
            PG8_LDA(At, 1, 1); PG8_STAGE(PG8_SB(1, 0), b3, voffB); PG8_STAGE(PG8_SB(1, 1), b3 + hstep, voffB); PG8_STAGE(PG8_SA(1, 0), a3, voffA);
            PG8_WAIT_V(8); PG8_WAIT_L(0); PG8_BAR; PG8_MMA(1, 0, At, B0); PG8_MMA(1, 1, At, B1); PG8_BAR; PG8_SCHED;
            } else {
            PG8_LDB(B0, 0, 0); PG8_SCHED; PG8_LDA(At, 0, 0); PG8_STAGE(PG8_SA(1, 1), a1 + hstep, voffA);
            PG8_WAIT_L(8); PG8_BAR; PG8_WAIT_L(0); PG8_MMA(0, 0, At, B0); PG8_BAR; PG8_SCHED;
            PG8_LDB(B1, 0, 1); PG8_STAGE(PG8_SB(0, 0), b2, voffB);
            PG8_BAR; PG8_WAIT_L(0); PG8_MMA(0, 1, At, B1); PG8_BAR;
            PG8_LDA(At, 0, 1); PG8_STAGE(PG8_SA(0, 0), a2, voffA);
            PG8_BAR; PG8_WAIT_L(0); PG8_MMA(1, 0, At, B0); PG8_BAR; PG8_SCHED;
            PG8_STAGE(PG8_SB(0, 1), b2 + hstep, voffB);
            PG8_WAIT_V(6); PG8_BAR; PG8_MMA(1, 1, At, B1); PG8_BAR;
            PG8_LDB(B0, 1, 0); PG8_SCHED; PG8_LDA(At, 1, 0); PG8_STAGE(PG8_SA(0, 1), a2 + hstep, voffA);
            PG8_WAIT_L(8); PG8_BAR; PG8_WAIT_L(0); PG8_MMA(0, 0, At, B0); PG8_BAR; PG8_SCHED;
            PG8_LDB(B1, 1, 1); PG8_STAGE(PG8_SB(1, 0), b3, voffB);
            PG8_BAR; PG8_WAIT_L(0); PG8_MMA(0, 1, At, B1); PG8_BAR;
            PG8_LDA(At, 1, 1); PG8_STAGE(PG8_SA(1, 0), a3, voffA);
            PG8_BAR; PG8_WAIT_L(0); PG8_MMA(1, 0, At, B0); PG8_BAR; PG8_SCHED;
            PG8_STAGE(PG8_SB(1, 1), b3 + hstep, voffB);
            PG8_WAIT_V(6); PG8_BAR; PG8_MMA(1, 1, At, B1); PG8_BAR;
            }
        }
        if constexpr (ALIGN_EPI) { if (wr == 0) PG8_BAR; }
        if constexpr (!Epi::AFTER_DRAIN) { E(acc, cur, wr, wc, fr, fq); S.done(cur); }
        if (!has_next) break;
#pragma unroll
        for (int a = 0; a < 2; ++a)
#pragma unroll
            for (int b = 0; b < 2; ++b)
#pragma unroll
                for (int m = 0; m < 4; ++m)
#pragma unroll
                    for (int n = 0; n < 2; ++n) acc[a][b][m][n] = (f32x4){0.f, 0.f, 0.f, 0.f};
        cur = nxt; cA = nA; cB = nB; ++ui;
        if constexpr (ALIGN_EPI) { if (wr == 1) PG8_BAR; }
    }
    PG8_WAIT_V(0);
    if constexpr (!ALIGN_EPI) { if (wr == 0) PG8_BAR; }
    PG8_BAR;
    if constexpr (Epi::AFTER_DRAIN) { E.fused(acc, cur, wr, wc, fr, fq, lds, wid, lane); S.done(cur); }
#undef PG8_SA
#undef PG8_SB
#undef PG8_STAGE
#undef PG8_LDA
#undef PG8_LDB
#undef PG8_MMA
#undef PG8_WAIT_V
#undef PG8_WAIT_L
#undef PG8_BAR
#undef PG8_SCHED
}
}
#define GAS __attribute__((address_space(1)))
#define LAS __attribute__((address_space(3)))
typedef unsigned short bf16;
typedef unsigned v4u __attribute__((ext_vector_type(4)));
typedef float f32x4 __attribute__((ext_vector_type(4)));
typedef short bf16x8 __attribute__((ext_vector_type(8)));
typedef GAS unsigned gu32;
typedef GAS unsigned long long gu64;
#define RLX_AGENT __ATOMIC_RELAXED, __HIP_MEMORY_SCOPE_AGENT
#define LDS_WAIT() asm volatile("s_waitcnt lgkmcnt(0)" ::: "memory")
#define VM_WAIT() asm volatile("s_waitcnt vmcnt(0)" ::: "memory")
__device__ __forceinline__ unsigned long long rt() { return __builtin_amdgcn_s_memrealtime(); }
__device__ __forceinline__ unsigned f2bf(float f) { unsigned u = __builtin_bit_cast(unsigned, f); return (u + 0x7fffu + ((u >> 16) & 1u)) >> 16; }
__device__ __forceinline__ unsigned pk2(float lo, float hi) { return f2bf(lo) | (f2bf(hi) << 16); }
#define XB_TMO      128
#define XB_XCNT(j)  (256  + 64 * (j))
#define XB_XSUB(j)  (1280 + 64 * (j))
#define XB_XGEN(j)  (2304 + 64 * (j))
#define XB_TOP      3328
#define XB_TOPGEN   3392
#define XCD_BAR_WORDS 3456
#define XB_SPIN_CAP (1u << 18)

__device__ __forceinline__ unsigned xb_ld(unsigned* p)              { return __hip_atomic_load(p, __ATOMIC_RELAXED, __HIP_MEMORY_SCOPE_AGENT); }
__device__ __forceinline__ unsigned xb_add(unsigned* p, unsigned v) { return __hip_atomic_fetch_add(p, v, __ATOMIC_RELAXED, __HIP_MEMORY_SCOPE_AGENT); }
__device__ __forceinline__ unsigned xb_xcc_id() { return (unsigned)__builtin_amdgcn_s_getreg((3 << 11) | 20) & 0xFu; }
#define XB_SPIN(cond, bar) do { unsigned _sp = 0; while (cond) { __builtin_amdgcn_s_sleep(1); \
    if ((++_sp & 255u) == 0u) { if (xb_ld(&(bar)[XB_TMO])) break; if (_sp > XB_SPIN_CAP) { atomicAdd(&(bar)[XB_TMO], 1u); break; } } } } while (0)

struct XcdBarrier {
    unsigned* bar; unsigned x;
    volatile LAS unsigned* st;
};

__device__ __forceinline__ XcdBarrier xcd_barrier_post(unsigned* bar, volatile LAS unsigned* st, bool t0) {
    XcdBarrier b; b.bar = bar; b.x = xb_xcc_id(); b.st = st;
    if (t0) (void)xb_add(&bar[XB_XCNT(b.x)], 1u);
    return b;
}
__device__ __forceinline__ void xcd_barrier_complete(unsigned* bar, unsigned x, unsigned& nloc, unsigned& nx) {
    const unsigned G = gridDim.x * gridDim.y * gridDim.z;
    unsigned sum, cnt, mine, sp = 0u;
    for (;;) {
        sum = 0u; cnt = 0u; mine = 0u;
#pragma unroll
        for (unsigned j = 0; j < 16; ++j) { const unsigned c = xb_ld(&bar[XB_XCNT(j)]); sum += c; cnt += (c > 0u) ? 1u : 0u; mine = (j == x) ? c : mine; }
        if (sum == G) break;
        __builtin_amdgcn_s_sleep(1);
        if ((++sp & 255u) == 0u) { if (xb_ld(&bar[XB_TMO])) break; if (sp > XB_SPIN_CAP) { atomicAdd(&bar[XB_TMO], 1u); break; } }
    }
    nloc = mine > 0u ? mine : 1u; nx = cnt > 0u ? cnt : 1u;
}

__device__ __forceinline__ void xcd_barrier(const XcdBarrier& b, bool t0) {
    asm volatile("s_waitcnt vmcnt(0)" ::: "memory");
    __syncthreads();
    if (t0) {
        unsigned* bar = b.bar;
        __builtin_amdgcn_s_waitcnt(0);
        unsigned nloc = b.st[0], nx = b.st[1];
        if (nloc == 0u) { xcd_barrier_complete(bar, b.x, nloc, nx); b.st[0] = nloc; b.st[1] = nx; }
        const unsigned old = xb_add(&bar[XB_XSUB(b.x)], 1u);
        const unsigned gen = old / nloc;
        if (old + 1u == (gen + 1u) * nloc) {
            __builtin_amdgcn_fence(__ATOMIC_RELEASE, "agent");
            asm volatile("s_waitcnt vmcnt(0)" ::: "memory");
            const unsigned og = xb_add(&bar[XB_TOP], 1u);
            const unsigned tg = og / nx;
            if (og + 1u == (tg + 1u) * nx) xb_add(&bar[XB_TOPGEN], 1u);
            else XB_SPIN(xb_ld(&bar[XB_TOPGEN]) == tg, bar);
            __builtin_amdgcn_fence(__ATOMIC_ACQUIRE, "agent");
            xb_add(&bar[XB_XGEN(b.x)], 1u);
            asm volatile("s_waitcnt vmcnt(0)" ::: "memory");
        } else {
            XB_SPIN(xb_ld(&bar[XB_XGEN(b.x)]) == gen, bar);
            __builtin_amdgcn_fence(__ATOMIC_ACQUIRE, "agent");
            asm volatile("s_waitcnt vmcnt(0)" ::: "memory");
        }
    }
    __syncthreads();
}

typedef float f32x16 __attribute__((ext_vector_type(16)));
typedef float f32x2v __attribute__((ext_vector_type(2)));
typedef unsigned u32x2v __attribute__((ext_vector_type(2)));
typedef short s16x4 __attribute__((ext_vector_type(4)));
#define MFMA32(a, b, c) __builtin_amdgcn_mfma_f32_32x32x16_bf16((a), (b), (c), 0, 0, 0)
#define MFMA16(a, b, c) __builtin_amdgcn_mfma_f32_16x16x32_bf16((a), (b), (c), 0, 0, 0)
__device__ __forceinline__ unsigned cvtpk(float lo, float hi) { return pg8::cvt_pk_bf16_c(lo, hi); }
__device__ __forceinline__ bf16x8 pack8(f32x4 a, f32x4 b) { v4u w; w.x = cvtpk(a[0], a[1]); w.y = cvtpk(a[2], a[3]); w.z = cvtpk(b[0], b[1]); w.w = cvtpk(b[2], b[3]); return __builtin_bit_cast(bf16x8, w); }
__device__ __forceinline__ float bf_lo(unsigned w) { return __uint_as_float(w << 16); }
__device__ __forceinline__ float bf_hi(unsigned w) { return __uint_as_float(w & 0xffff0000u); }
__device__ __forceinline__ int lane_id() { int l; asm volatile("v_mbcnt_lo_u32_b32 %0, -1, 0\n\tv_mbcnt_hi_u32_b32 %0, -1, %0" : "=v"(l)); return l; }
__device__ __forceinline__ int crow(int reg, int h) { return (reg & 3) + 8 * (reg >> 2) + 4 * h; }

struct Params {
    const float *x_p, *x_s, *cache_k, *cache_v, *cache_kidx, *state_ret; const int* page_table;
    const float *p_p, *p_s, *rel_bias, *w_in, *w_out, *g_pre, *g_post, *w_up, *w_gate;
    float* out; unsigned char* ws;
    int ph_lo, ph_hi;
};

__device__ __forceinline__ int win_src_col(int n) {
    if (n < 1352) return n;
    if (n < 1536) return -1;
    if (n < 2048) return C_GA + (n - 1536);
    if (n < 3072) { const int base = (n < 2560) ? C_QB : C_KB; const int f = (n - 2048) & 511, hh = f >> 6, p = f & 63, d = (p & 1) ? 32 + (p >> 1) : (p >> 1); return base + hh * 64 + d; }
    if (n < 3584) return C_VB + (n - 3072);
    return C_GB + (n - 3584);
}
__device__ __forceinline__ void p0_transpose_item(const float* W, int ldw, int K, const float* gk, bf16* WT, int kb, int nb, int srccol, LAS float* scr, int lane) {
    const int k0 = 64 * kb, n0 = 32 * nb;
#pragma unroll 8
    for (int i = 0; i < 32; ++i) { const int kk = 2 * i + (lane >> 5); float v = 0.f; if (srccol >= 0) v = W[(size_t)(k0 + kk) * ldw + srccol]; if (gk) v *= gk[k0 + kk]; scr[kk * 33 + (lane & 31)] = v; }
    LDS_WAIT(); asm volatile("" ::: "memory");
    const int c = lane & 7;
#pragma unroll
    for (int j = 0; j < 4; ++j) { const int n = (lane >> 3) + 8 * j; const LAS float* s = scr + (8 * c) * 33 + n;
        v4u o; o.x = cvtpk(s[0 * 33], s[1 * 33]); o.y = cvtpk(s[2 * 33], s[3 * 33]); o.z = cvtpk(s[4 * 33], s[5 * 33]); o.w = cvtpk(s[6 * 33], s[7 * 33]);
        *(GAS v4u*)(WT + (size_t)(n0 + n) * K + k0 + 8 * c) = o; }
    LDS_WAIT(); asm volatile("" ::: "memory");
}
__device__ __forceinline__ float wave_sum(float v) {
#pragma unroll
    for (int o = 1; o < 64; o <<= 1) v += __shfl_xor(v, o);
    return v;
}
__device__ __forceinline__ void sincos_d(double a, double& s, double& c) {
    const double TWO_PI = 6.283185307179586476925286766559, INV_2PI = 0.15915494309189533576888376337251;
    const double n = __builtin_rint(a * INV_2PI); double r = __builtin_fma(-n, TWO_PI, a); r = __builtin_fma(-n, 2.4492935982947064e-16, r);
    const double r2 = r * r; double ts = 1.0, tc = 1.0, ss = 1.0, cc = 1.0;
#pragma unroll
    for (int k = 1; k <= 14; ++k) { tc = -tc * r2 / (double)((2 * k - 1) * (2 * k)); cc += tc; ts = -ts * r2 / (double)((2 * k) * (2 * k + 1)); ss += ts; }
    s = r * ss; c = cc;
}
__device__ __forceinline__ void p0_sample_inproj(const Params& P, int unit, int wave, int lane) {
    const int col = unit * 16 + (lane & 15); const bool cv = col < D_IN; const int kg = lane >> 4, row = wave * 16 + (lane & 15);
    const float* xr = P.x_s + (size_t)row * DM; const float* wc = P.w_in + (cv ? col : 0);
    f32x4 acc = {0.f, 0.f, 0.f, 0.f}; float ss = 0.f;
#pragma unroll 2
    for (int ks = 0; ks < 32; ++ks) { const int k0 = 32 * ks + 8 * kg;
        const f32x4 xa = *(const f32x4*)(xr + k0), xb = *(const f32x4*)(xr + k0 + 4), ga = *(const f32x4*)(P.g_pre + k0), gb = *(const f32x4*)(P.g_pre + k0 + 4);
        ss += (xa[0] * xa[0] + xa[1] * xa[1]) + (xa[2] * xa[2] + xa[3] * xa[3]) + (xb[0] * xb[0] + xb[1] * xb[1]) + (xb[2] * xb[2] + xb[3] * xb[3]);
        const bf16x8 a = pack8(xa * ga, xb * gb);
        float wv[8];
#pragma unroll
        for (int j = 0; j < 8; ++j) wv[j] = cv ? wc[(size_t)(k0 + j) * D_IN] : 0.f;
        const bf16x8 b = pack8((f32x4){wv[0], wv[1], wv[2], wv[3]}, (f32x4){wv[4], wv[5], wv[6], wv[7]});
        acc = MFMA16(a, b, acc); }
    ss += __shfl_xor(ss, 16); ss += __shfl_xor(ss, 32);
    const float rstd = 1.0f / sqrtf(ss * (1.0f / DM) + EPS);
#pragma unroll
    for (int j = 0; j < 4; ++j) { const int r = kg * 4 + j; const float rs = __shfl(rstd, r); const float z = acc[j] * rs; const int grow = wave * 16 + r;
        if (cv) { float* zs = (float*)(P.ws + WS_ZS); zs[(size_t)grow * D_IN + col] = z;
            if (col >= C_KA && col < C_VA) P.out[O_KS + (size_t)grow * 128 + (col - C_KA)] = z;
            else if (col >= C_VA && col < C_QI) P.out[O_VS + (size_t)grow * 128 + (col - C_VA)] = z;
            else if (col >= C_KI && col < C_WI) P.out[O_KIS + (size_t)grow * 64 + (col - C_KI)] = z; } }
}
__device__ __forceinline__ int t5_bucket(int n) {
    if (n < 16) return n;
    const int l = 16 + (int)(__builtin_amdgcn_logf((float)n * 0.0625f) * (16.0f / 3.0f) + 1e-4f);
    return l < 31 ? l : 31;
}
__device__ __forceinline__ void p0_prologue(const Params& P, LAS unsigned char* lds, int vcu, int G, int wave, int lane, int tid) {
    LAS float* scr = (LAS float*)(lds + wave * 16384);
    const int gw = vcu * NWAVES + wave, NGW = G * NWAVES;
    bf16* win_t = (bf16*)(P.ws + WS_WIN); bf16* wout_t = (bf16*)(P.ws + WS_WOUT); bf16* wgate_t = (bf16*)(P.ws + WS_WGATE); bf16* wup_t = (bf16*)(P.ws + WS_WUP);
    constexpr int I_IN = (DM / 64) * (NPAD / 32), I_SQ = (DM / 64) * (DM / 32), I_UP = (DPLE / 64) * (DM / 32);
    constexpr int NITEMS = I_IN + 2 * I_SQ + I_UP;
    for (int it = gw; it < NITEMS; it += NGW) {
        int r = it;
        if (r < I_IN) { const int nblk = NPAD / 32, kb = r / nblk, nb = r % nblk; p0_transpose_item(P.w_in, D_IN, DM, P.g_pre, win_t, kb, nb, win_src_col(nb * 32 + (lane & 31)), scr, lane); continue; } r -= I_IN;
        if (r < I_SQ) { const int nblk = DM / 32, kb = r / nblk, nb = r % nblk; p0_transpose_item(P.w_out, DM, DM, nullptr, wout_t, kb, nb, nb * 32 + (lane & 31), scr, lane); continue; } r -= I_SQ;
        if (r < I_SQ) { const int nblk = DM / 32, kb = r / nblk, nb = r % nblk; p0_transpose_item(P.w_gate, DM, DM, nullptr, wgate_t, kb, nb, nb * 32 + (lane & 31), scr, lane); continue; } r -= I_SQ;
        { const int nblk = DM / 32, kb = r / nblk, nb = r % nblk; p0_transpose_item(P.w_up, DM, DPLE, nullptr, wup_t, kb, nb, nb * 32 + (lane & 31), scr, lane); }
    }
    bf16* xb = (bf16*)(P.ws + WS_XB); float* rstd = (float*)(P.ws + WS_RSTD);
    for (int m = gw; m < M; m += NGW) {
        const GAS f32x4* xr = (const GAS f32x4*)(P.x_p + (size_t)m * DM) + lane;
        f32x4 v[4]; float s = 0.f;
#pragma unroll
        for (int j = 0; j < 4; ++j) { v[j] = xr[64 * j]; s += (v[j].x * v[j].x + v[j].y * v[j].y) + (v[j].z * v[j].z + v[j].w * v[j].w); }
        s = wave_sum(s);
        GAS u32x2v* o8 = (GAS u32x2v*)(xb + (size_t)m * DM) + lane;
#pragma unroll
        for (int j = 0; j < 4; ++j) { u32x2v w; w.x = cvtpk(v[j].x, v[j].y); w.y = cvtpk(v[j].z, v[j].w); o8[64 * j] = w; }
        if (lane == 0) rstd[m] = 1.0f / sqrtf(s * (1.0f / DM) + EPS);
    }
    { bf16* pb = (bf16*)(P.ws + WS_PB); const int NT = G * NWAVES * 64, gt = gw * 64 + lane;
      for (int i = gt; i < M * DPLE / 8; i += NT) { const f32x4 a = *(const f32x4*)(P.p_p + (size_t)i * 8), b = *(const f32x4*)(P.p_p + (size_t)i * 8 + 4); *(bf16x8*)(pb + (size_t)i * 8) = pack8(a, b); }
      float* rope = (float*)(P.ws + WS_ROPE);
      for (int i = gt; i < 2052 * 32; i += NT) { const int p = i >> 5, fi = i & 31; const int pos = p < 2048 ? p : PAST + (p - 2048);
          const float inv = (float)exp2(-(double)fi * (13.287712379549449 / 32.0));
          const float ang = (float)pos * inv; double s, c; sincos_d((double)ang, s, c); rope[(size_t)i * 2] = (float)c; rope[(size_t)i * 2 + 1] = (float)s; }
      float* bias2 = (float*)(P.ws + WS_BIAS);
      for (int i = gt; i < 128 * 8; i += NT) { const int n = i >> 3, hd = i & 7; bias2[i] = P.rel_bias[t5_bucket(n) * 8 + hd] * LOG2E; }
    }
    if (vcu < (D_IN + 15) / 16) p0_sample_inproj(P, vcu, wave, lane);
}

__device__ __forceinline__ void p1_sample_index(const Params& P, int unit, int wave, int lane) {
    const int b = unit >> 3, js = unit & 7, r = lane & 31, h = lane >> 5;
    const float* zs = (const float*)(P.ws + WS_ZS); float* scs = (float*)(P.ws + WS_SCS);
    const int cq = (r >> 2) & 1, a = r >> 3, e = r & 3, q = 2 * cq + (a >> 1), hd = 4 * (a & 1) + e;
    const float* zq = zs + (size_t)(b * 4 + q) * D_IN + C_QI + hd * 64 + 32 * h;
    bf16x8 af[4];
#pragma unroll
    for (int s = 0; s < 4; ++s) af[s] = pack8(*(const f32x4*)(zq + 8 * s), *(const f32x4*)(zq + 8 * s + 4));
    float w[16];
#pragma unroll
    for (int i = 0; i < 16; ++i) w[i] = zs[(size_t)(b * 4 + 2 * h + (i >> 3)) * D_IN + C_WI + (i & 7)] * WSCALE;
    for (int pi = 0; pi < 2; ++pi) {
        const int lp = js * 16 + wave * 2 + pi; const int phys = P.page_table[b * NPG + lp];
        const float* kp = P.cache_kidx + (size_t)phys * PAGE * 64;
#pragma unroll 2
        for (int tile = 0; tile < 4; ++tile) {
            const float* kr = kp + (size_t)(tile * 32 + r) * 64 + 32 * h;
            f32x4 kv[8];
#pragma unroll
            for (int j = 0; j < 8; ++j) kv[j] = *(const f32x4*)(kr + 4 * j);
            f32x16 acc = {};
#pragma unroll
            for (int s = 0; s < 4; ++s) acc = MFMA32(af[s], pack8(kv[2 * s], kv[2 * s + 1]), acc);
            float s0 = 0.f, s1 = 0.f;
#pragma unroll
            for (int i = 0; i < 8; ++i) { s0 += w[i] * fmaxf(acc[i], 0.f); s1 += w[8 + i] * fmaxf(acc[8 + i], 0.f); }
            const int pos = lp * PAGE + tile * 32 + r;
            scs[(size_t)(b * 4 + 2 * h) * PAST + pos] = s0; scs[(size_t)(b * 4 + 2 * h + 1) * PAST + pos] = s1;
        }
    }
}

__device__ __forceinline__ float bfu(bf16 v) { return __uint_as_float((unsigned)v << 16); }
__device__ __forceinline__ unsigned fkey(float x) { const unsigned u = __float_as_uint(x); return (u & 0x80000000u) ? ~u : (u | 0x80000000u); }
__device__ __forceinline__ float block_sum(float v, LAS float* red, int wave, int lane) {
    v = wave_sum(v); if (lane == 0) red[wave] = v; __syncthreads();
    float s = 0.f;
#pragma unroll
    for (int w = 0; w < NWAVES; ++w) s += red[w];
    __syncthreads(); return s;
}

__device__ __forceinline__ void np2_dsa_query(const Params& P, LAS unsigned char* lds, int m, int tid, int wave, int lane) {
    const int b = m >> 11, t = m & 2047, nk = t + 1;
    LAS float* sc = (LAS float*)lds; LAS float* qi = sc + 2048; LAS float* wi = qi + 512; LAS int* sel = (LAS int*)(wi + 8); LAS int* nselp = sel + 256;
    LAS float* lg = (LAS float*)(nselp + 8); LAS float* qa = lg + 2048; LAS float* red = qa + 512;
    const bf16* QI = (const bf16*)(P.ws + WS_QI); const bf16* KI = (const bf16*)(P.ws + WS_KI); const float* WI = (const float*)(P.ws + WS_WI);
    const bf16* QA = (const bf16*)(P.ws + WS_QA); const bf16* KA = (const bf16*)(P.ws + WS_KA); const bf16* VA = (const bf16*)(P.ws + WS_VA); const bf16* GA = (const bf16*)(P.ws + WS_GA);
    const float* bias2 = (const float*)(P.ws + WS_BIAS); bf16* YM = (bf16*)(P.ws + WS_YM);
    qi[tid] = bfu(QI[(size_t)m * 512 + tid]); qa[tid] = bfu(QA[(size_t)m * 512 + tid]); if (tid < 8) wi[tid] = WI[(size_t)m * 8 + tid]; if (tid == 0) nselp[0] = 0;
    __syncthreads();
    for (int s = tid; s < nk; s += 512) {
        const bf16* kr = KI + (size_t)(b * T + s) * 64; float kf[64];
#pragma unroll
        for (int j = 0; j < 8; ++j) { const v4u w = *(const v4u*)(kr + 8 * j); kf[8 * j] = bf_lo(w.x); kf[8 * j + 1] = bf_hi(w.x); kf[8 * j + 2] = bf_lo(w.y); kf[8 * j + 3] = bf_hi(w.y); kf[8 * j + 4] = bf_lo(w.z); kf[8 * j + 5] = bf_hi(w.z); kf[8 * j + 6] = bf_lo(w.w); kf[8 * j + 7] = bf_hi(w.w); }
        float score = 0.f;
        for (int hd = 0; hd < 8; ++hd) { float d = 0.f;
#pragma unroll
            for (int j = 0; j < 64; ++j) d += qi[hd * 64 + j] * kf[j];
            score += wi[hd] * fmaxf(d, 0.f); }
        sc[s] = score;
    }
    __syncthreads();
    int nsel;
    if (nk <= 256) { for (int s = tid; s < nk; s += 512) sel[s] = s; nsel = nk; }
    else {
        for (int s = tid; s < nk; s += 512) { const float x = sc[s]; int rank = 0;
            for (int s2 = 0; s2 < nk; ++s2) { const float y = sc[s2]; rank += (y > x || (y == x && s2 < s)) ? 1 : 0; }
            if (rank < 256) { const int pos = atomicAdd((int*)nselp, 1); sel[pos] = s; } }
        nsel = 256;
    }
    __syncthreads();
    for (int idx = tid; idx < 8 * nsel; idx += 512) { const int hd = idx & 7, k = idx >> 3, s = sel[k]; const bf16* kr = KA + (size_t)(b * T + s) * 128 + (hd >> 2) * 64; float d = 0.f;
#pragma unroll
        for (int j = 0; j < 8; ++j) { const v4u w = *(const v4u*)(kr + 8 * j); const LAS float* q = qa + hd * 64 + 8 * j;
            d += q[0] * bf_lo(w.x) + q[1] * bf_hi(w.x) + q[2] * bf_lo(w.y) + q[3] * bf_hi(w.y) + q[4] * bf_lo(w.z) + q[5] * bf_hi(w.z) + q[6] * bf_lo(w.w) + q[7] * bf_hi(w.w); }
        const int dist = t - s; lg[hd * 256 + k] = d + bias2[(dist < 127 ? dist : 127) * 8 + hd]; }
    __syncthreads();
    { const int hd = wave; float mx = -3.0e38f; for (int k = lane; k < nsel; k += 64) mx = fmaxf(mx, lg[hd * 256 + k]);
#pragma unroll
      for (int o = 1; o < 64; o <<= 1) mx = fmaxf(mx, __shfl_xor(mx, o));
      float sum = 0.f; for (int k = lane; k < nsel; k += 64) { const float p = __builtin_amdgcn_exp2f(lg[hd * 256 + k] - mx); lg[hd * 256 + k] = p; sum += p; }
      sum = wave_sum(sum); if (lane == 0) red[hd] = 1.0f / sum; }
    __syncthreads();
    { const int hd = tid >> 6, d = tid & 63; float acc = 0.f;
      for (int k = 0; k < nsel; ++k) acc += lg[hd * 256 + k] * bfu(VA[(size_t)(b * T + sel[k]) * 128 + (hd >> 2) * 64 + d]);
      const float o = acc * red[hd] * bfu(GA[(size_t)m * 512 + tid]);
      YM[(size_t)m * DM + tid] = (bf16)(cvtpk(o, 0.f) & 0xffffu); }
    __syncthreads();
}

__device__ __forceinline__ void np2_ret_block(const Params& P, LAS unsigned char* lds, int unit, int tid, int wave, int lane) {
    const int tb = unit & 255, h = (unit >> 8) & 7, b = unit >> 11; const int tl = tid >> 6, dv = tid & 63, t = tb * 8 + tl, m = b * T + t;
    LAS float* qs = (LAS float*)lds; LAS float* wts = qs + 512;
    const bf16* QB = (const bf16*)(P.ws + WS_QB); const bf16* KB = (const bf16*)(P.ws + WS_KB); const bf16* VB = (const bf16*)(P.ws + WS_VB); const bf16* GB = (const bf16*)(P.ws + WS_GB); bf16* YM = (bf16*)(P.ws + WS_YM);
    const float l2g = pg8::log2g_of(h);
    qs[tid] = bfu(QB[(size_t)m * 512 + h * 64 + dv]);
    __syncthreads();
    float acc = 0.f; const int tmax = tb * 8 + 7;
    for (int s0 = 0; s0 <= tmax; s0 += 64) {
        { const int s = s0 + dv; float w = 0.f;
          if (s <= t) { const bf16* kr = KB + (size_t)(b * T + s) * 512 + h * 64; float d = 0.f;
#pragma unroll
              for (int j = 0; j < 8; ++j) { const v4u kw = *(const v4u*)(kr + 8 * j); const LAS float* q = qs + tl * 64 + 8 * j;
                  d += q[0] * bf_lo(kw.x) + q[1] * bf_hi(kw.x) + q[2] * bf_lo(kw.y) + q[3] * bf_hi(kw.y) + q[4] * bf_lo(kw.z) + q[5] * bf_hi(kw.z) + q[6] * bf_lo(kw.w) + q[7] * bf_hi(kw.w); }
              w = d * __builtin_amdgcn_exp2f(128.0f * l2g * (float)((t >> 7) - (s >> 7))); }
          wts[tl * 64 + dv] = w; }
        __syncthreads();
        const int ns = (tmax - s0 + 1) < 64 ? (tmax - s0 + 1) : 64;
        for (int sl = 0; sl < ns; ++sl) acc += wts[tl * 64 + sl] * bfu(VB[(size_t)(b * T + s0 + sl) * 512 + h * 64 + dv]);
        __syncthreads();
    }
    const float mu = wave_sum(acc) * (1.0f / 64.0f); const float dlt = acc - mu; const float var = wave_sum(dlt * dlt) * (1.0f / 64.0f);
    const float y = dlt * (1.0f / sqrtf(var + EPS)) * bfu(GB[(size_t)m * 512 + h * 64 + dv]);
    YM[(size_t)m * DM + 512 + h * 64 + dv] = (bf16)(cvtpk(y, 0.f) & 0xffffu);
    __syncthreads();
}
__device__ __forceinline__ void np2_ret_state(const Params& P, int unit, int tid) {
    const int h = unit & 7, b = unit >> 3; const int p = tid >> 3, dv0 = (tid & 7) * 8; const float l2g = pg8::log2g_of(h);
    const bf16* KB = (const bf16*)(P.ws + WS_KB); const bf16* VB = (const bf16*)(P.ws + WS_VB);
    float acc[8];
#pragma unroll
    for (int j = 0; j < 8; ++j) acc[j] = 0.f;
    for (int s = 0; s < T; ++s) { const float coef = __builtin_amdgcn_exp2f(l2g * (float)(128 * (15 - (s >> 7)) + 127)); const float kk = bfu(KB[(size_t)(b * T + s) * 512 + h * 64 + p]) * coef;
        const v4u vw = *(const v4u*)(VB + (size_t)(b * T + s) * 512 + h * 64 + dv0);
        acc[0] += kk * bf_lo(vw.x); acc[1] += kk * bf_hi(vw.x); acc[2] += kk * bf_lo(vw.y); acc[3] += kk * bf_hi(vw.y); acc[4] += kk * bf_lo(vw.z); acc[5] += kk * bf_hi(vw.z); acc[6] += kk * bf_lo(vw.w); acc[7] += kk * bf_hi(vw.w); }
    const int d = (p & 1) ? 32 + (p >> 1) : (p >> 1);
    float* o = P.out + O_RSP + ((size_t)(b * 8 + h) * 64 + d) * 64 + dv0;
    *(f32x4*)o = (f32x4){acc[0], acc[1], acc[2], acc[3]}; *(f32x4*)(o + 4) = (f32x4){acc[4], acc[5], acc[6], acc[7]};
}

__device__ __forceinline__ int block_count(int c, LAS int* red, int wave, int lane) {
#pragma unroll
    for (int o = 1; o < 64; o <<= 1) c += __shfl_xor(c, o);
    if (lane == 0) red[wave] = c; __syncthreads();
    int s = 0;
#pragma unroll
    for (int w = 0; w < NWAVES; ++w) s += red[w];
    __syncthreads(); return s;
}
__device__ __forceinline__ void p2_sample_attn(const Params& P, LAS unsigned char* lds, int unit, int tid, int wave, int lane) {
    const int b = unit >> 2, q = unit & 3, row = unit, qpos = PAST + q;
    const float* zs = (const float*)(P.ws + WS_ZS); const float* scs = (const float*)(P.ws + WS_SCS); const float* bias2 = (const float*)(P.ws + WS_BIAS);
    LAS float* vl = (LAS float*)lds;
    LAS float* lg = (LAS float*)(lds + AUX_OFF);
    LAS float* qa = lg + 2048;
    LAS int* sel = (LAS int*)(qa + 512);
    LAS int* red = sel + 256;
    LAS float* rinv = (LAS float*)(red + 16);
    LAS int* cntp = (LAS int*)(rinv + 8);
    LAS float* qi = (LAS float*)lds;
    qi[tid] = zs[(size_t)row * D_IN + C_QI + tid]; qa[tid] = zs[(size_t)row * D_IN + C_QA + tid] * 0.18033688011112042f; if (tid == 0) cntp[0] = 0;
    __syncthreads();
    unsigned key[33];
#pragma unroll
    for (int j = 0; j < 32; ++j) key[j] = fkey(scs[(size_t)row * PAST + j * 512 + tid]);
    key[32] = 0u;
    if (tid < 4 && tid <= q) { const float* kn = zs + (size_t)(b * 4 + tid) * D_IN + C_KI; float score = 0.f;
        for (int hd = 0; hd < 8; ++hd) { float d = 0.f; for (int j = 0; j < 64; ++j) d += qi[hd * 64 + j] * kn[j]; score += zs[(size_t)row * D_IN + C_WI + hd] * WSCALE * fmaxf(d, 0.f); }
        key[32] = fkey(score); }
    __syncthreads();
    unsigned ans = 0u; bool exact = false;
    for (int bit = 31; bit >= 0; --bit) { const unsigned cand = ans | (1u << bit); int c = 0;
#pragma unroll
        for (int j = 0; j < 33; ++j) c += (key[j] >= cand) ? 1 : 0;
        c = block_count(c, red, wave, lane);
        if (c >= 256) ans = cand;
        if (c == 256) { exact = true; break; } }
    int n_ge = 256;
    if (!exact) { int c = 0;
#pragma unroll
        for (int j = 0; j < 33; ++j) c += (key[j] >= ans) ? 1 : 0;
        n_ge = block_count(c, red, wave, lane); }
    const bool ties = n_ge != 256;
#pragma unroll
    for (int j = 0; j < 33; ++j) { const bool s = ties ? (key[j] > ans) : (key[j] >= ans); if (s) { const int pos = atomicAdd((int*)cntp, 1); sel[pos] = (j < 32) ? j * 512 + tid : PAST + tid; } }
    __syncthreads();
    if (ties && wave == 0) {
        int have = cntp[0];
        for (int ch = 0; ch < (PAST + 4 + 63) / 64 && have < 256; ++ch) { const int pos = ch * 64 + lane; unsigned k = 0u;
            if (pos < PAST) k = fkey(scs[(size_t)row * PAST + pos]);
            else if (pos - PAST <= q) { const float* kn = zs + (size_t)(b * 4 + pos - PAST) * D_IN + C_KI; float score = 0.f;
                for (int hd = 0; hd < 8; ++hd) { float d = 0.f; for (int j = 0; j < 64; ++j) d += zs[(size_t)row * D_IN + C_QI + hd * 64 + j] * kn[j]; score += zs[(size_t)row * D_IN + C_WI + hd] * WSCALE * fmaxf(d, 0.f); }
                k = fkey(score); }
            const bool eq = (k == ans) && (pos < PAST + 4); unsigned long long mk = __ballot(eq);
            const int before = __popcll(mk & ((1ull << lane) - 1ull));
            if (eq && have + before < 256) sel[have + before] = pos;
            have += __popcll(mk); }
    }
    __syncthreads();
    { const int k = tid >> 1, n = tid & 1, idx = sel[k]; const float* kr;
      if (idx < PAST) { const int phys = P.page_table[b * NPG + (idx >> 7)]; kr = P.cache_k + ((size_t)phys * PAGE + (idx & 127)) * 128 + n * 64; }
      else kr = zs + (size_t)(b * 4 + idx - PAST) * D_IN + C_KA + n * 64;
      f32x4 kv[16];
#pragma unroll
      for (int j = 0; j < 16; ++j) kv[j] = *(const f32x4*)(kr + 4 * j);
      const int dist = qpos - idx; const int bi = (dist < 127 ? dist : 127) * 8;
#pragma unroll
      for (int g = 0; g < 4; ++g) { const int hd = 4 * n + g; float d = 0.f;
#pragma unroll
          for (int j = 0; j < 16; ++j) { const LAS float* qq = qa + hd * 64 + 4 * j; d += qq[0] * kv[j][0] + qq[1] * kv[j][1] + qq[2] * kv[j][2] + qq[3] * kv[j][3]; }
          lg[hd * 256 + k] = d + bias2[bi + hd]; }
    }
    __syncthreads();
    { const int hd = wave; float mx = -3.0e38f; for (int k = lane; k < 256; k += 64) mx = fmaxf(mx, lg[hd * 256 + k]);
#pragma unroll
      for (int o = 1; o < 64; o <<= 1) mx = fmaxf(mx, __shfl_xor(mx, o));
      float sum = 0.f; for (int k = lane; k < 256; k += 64) { const float p = __builtin_amdgcn_exp2f(lg[hd * 256 + k] - mx); lg[hd * 256 + k] = p; sum += p; }
      sum = wave_sum(sum); if (lane == 0) rinv[hd] = 1.0f / sum; }
    { const int k = tid >> 1, n = tid & 1, idx = sel[k]; const float* vr;
      if (idx < PAST) { const int phys = P.page_table[b * NPG + (idx >> 7)]; vr = P.cache_v + ((size_t)phys * PAGE + (idx & 127)) * 128 + n * 64; }
      else vr = zs + (size_t)(b * 4 + idx - PAST) * D_IN + C_VA + n * 64;
#pragma unroll
      for (int j = 0; j < 16; ++j) *(LAS f32x4*)(vl + k * 128 + n * 64 + 4 * j) = *(const f32x4*)(vr + 4 * j);
    }
    __syncthreads();
    { const int hd = tid >> 6, d = tid & 63; float acc = 0.f;
      for (int k = 0; k < 256; ++k) acc += lg[hd * 256 + k] * vl[k * 128 + (hd >> 2) * 64 + d];
      const float o = acc * rinv[hd] * pg8::silu_f(zs[(size_t)row * D_IN + C_GA + tid]);
      ((bf16*)(P.ws + WS_YMS))[(size_t)row * DM + tid] = (bf16)(cvtpk(o, 0.f) & 0xffffu); }
    __syncthreads();
}

__device__ __forceinline__ void p2_sample_ret(const Params& P, LAS unsigned char* lds, int unit, int tid, int wave, int lane) {
    const int h = unit & 7, b = unit >> 3; const float* zs = (const float*)(P.ws + WS_ZS); const float* rope = (const float*)(P.ws + WS_ROPE);
    LAS float* qs = (LAS float*)lds; LAS float* ks = qs + 256; LAS float* vs = ks + 256; LAS float* qk = vs + 256; LAS float* part = qk + 16;
    const float l2g = pg8::log2g_of(h);
    if (tid < 256) { const int i = tid >> 6, d = tid & 63, row = b * 4 + i; const float* zr = zs + (size_t)row * D_IN; const int fi = d & 31;
        const float c = rope[((size_t)(2048 + i) * 32 + fi) * 2], s = rope[((size_t)(2048 + i) * 32 + fi) * 2 + 1];
        const float q1 = zr[C_QB + h * 64 + fi], q2 = zr[C_QB + h * 64 + 32 + fi], k1 = zr[C_KB + h * 64 + fi], k2 = zr[C_KB + h * 64 + 32 + fi];
        qs[tid] = (d < 32) ? (q1 * c - q2 * s) : (q1 * s + q2 * c); ks[tid] = 0.125f * ((d < 32) ? (k1 * c - k2 * s) : (k1 * s + k2 * c)); vs[tid] = zr[C_VB + h * 64 + d]; }
    __syncthreads();
    if (tid < 16) { const int i = tid >> 2, j = tid & 3; float d = 0.f; for (int e = 0; e < 64; ++e) d += qs[i * 64 + e] * ks[j * 64 + e]; qk[tid] = d; }
    { const int dkg = tid >> 6, dv = tid & 63; const float g4 = __builtin_amdgcn_exp2f(4.0f * l2g); float pi[4] = {0.f, 0.f, 0.f, 0.f};
      const float* s0p = P.state_ret + ((size_t)(b * 8 + h) * 64 + dkg * 8) * 64 + dv; float* sop = P.out + O_RSS + ((size_t)(b * 8 + h) * 64 + dkg * 8) * 64 + dv;
#pragma unroll
      for (int e = 0; e < 8; ++e) { const int dk = dkg * 8 + e; const float s0 = s0p[e * 64]; float sn = g4 * s0;
#pragma unroll
          for (int i = 0; i < 4; ++i) { sn += __builtin_amdgcn_exp2f((float)(3 - i) * l2g) * ks[i * 64 + dk] * vs[i * 64 + dv]; pi[i] += qs[i * 64 + dk] * s0; }
          sop[e * 64] = sn; }
#pragma unroll
      for (int i = 0; i < 4; ++i) part[(dkg * 4 + i) * 64 + dv] = pi[i]; }
    __syncthreads();
    if (tid < 256) { const int i = tid >> 6, dv = tid & 63, row = b * 4 + i; float inter = 0.f;
#pragma unroll
        for (int g = 0; g < 8; ++g) inter += part[(g * 4 + i) * 64 + dv];
        float o = inter * __builtin_amdgcn_exp2f((float)(i + 1) * l2g);
        for (int j = 0; j <= i; ++j) o += __builtin_amdgcn_exp2f((float)(i - j) * l2g) * qk[i * 4 + j] * vs[j * 64 + dv];
        const float mu = wave_sum(o) * (1.0f / 64.0f), dl = o - mu, var = wave_sum(dl * dl) * (1.0f / 64.0f);
        const float y = dl * (1.0f / sqrtf(var + EPS)) * pg8::silu_f(zs[(size_t)row * D_IN + C_GB + h * 64 + dv]);
        ((bf16*)(P.ws + WS_YMS))[(size_t)row * DM + 512 + h * 64 + dv] = (bf16)(cvtpk(y, 0.f) & 0xffffu); }
    __syncthreads();
}

__device__ __forceinline__ void p3_sample_merge(const Params& P, LAS unsigned char* lds, int row, int tid, int wave, int lane) {
    LAS float* a = (LAS float*)lds; LAS float* x1 = a + 1024; LAS float* pp = x1 + 1024; LAS float* red = pp + 256;
    const bf16* yms = (const bf16*)(P.ws + WS_YMS);
    a[tid] = bfu(yms[(size_t)row * DM + tid]); a[tid + 512] = bfu(yms[(size_t)row * DM + 512 + tid]); if (tid < 256) pp[tid] = P.p_s[(size_t)row * DPLE + tid];
    __syncthreads();
    float y0 = 0.f, y1 = 0.f;
    for (int k = 0; k < DM; ++k) { const float av = a[k]; y0 += av * P.w_out[(size_t)k * DM + tid]; y1 += av * P.w_out[(size_t)k * DM + 512 + tid]; }
    const float ssq = block_sum(y0 * y0 + y1 * y1, red, wave, lane); const float rs = 1.0f / sqrtf(ssq * (1.0f / DM) + EPS);
    const float xa = P.x_s[(size_t)row * DM + tid] + y0 * rs * P.g_post[tid], xb = P.x_s[(size_t)row * DM + 512 + tid] + y1 * rs * P.g_post[512 + tid];
    x1[tid] = xa; x1[tid + 512] = xb;
    __syncthreads();
    float g0 = 0.f, g1 = 0.f, p0 = 0.f, p1 = 0.f;
    for (int k = 0; k < DM; ++k) { const float xv = x1[k]; g0 += xv * P.w_gate[(size_t)k * DM + tid]; g1 += xv * P.w_gate[(size_t)k * DM + 512 + tid]; }
    for (int k = 0; k < DPLE; ++k) { const float pv = pp[k]; p0 += pv * P.w_up[(size_t)k * DM + tid]; p1 += pv * P.w_up[(size_t)k * DM + 512 + tid]; }
    P.out[O_YS + (size_t)row * DM + tid] = xa + p0 * pg8::sigmoid_f(g0); P.out[O_YS + (size_t)row * DM + 512 + tid] = xb + p1 * pg8::sigmoid_f(g1);
    __syncthreads();
}

constexpr int DSA_KST = 0, DSA_KROW = 272, DSA_VST = 34816, DSA_VROW = 320, DSA_XCH = 75776;
typedef short v4i16_t __attribute__((ext_vector_type(4)));
__device__ __forceinline__ s16x4 tr_read(LAS unsigned char* p) { return __builtin_bit_cast(s16x4, __builtin_amdgcn_ds_read_tr16_b64_v4i16((LAS v4i16_t*)p)); }

template <int NJ>
__device__ __forceinline__ void dsa_select_row(LAS float* scrow, LAS unsigned* mrow, int tq, int nj, int lane) {
    unsigned key[NJ];
#pragma unroll
    for (int j = 0; j < NJ; ++j) { const int kidx = j * 64 + lane; const unsigned kk = fkey(scrow[kidx]); key[j] = (kidx <= tq) ? kk : 0u; }
    unsigned thr = 1u;
    bool ties = false; int n_gt = 0;
    if (tq + 1 > 256) {
        unsigned ans = 0u; bool exact = false;
        for (int bit = 31; bit >= 0; --bit) { const unsigned cand = ans | (1u << bit); int c = 0;
#pragma unroll
            for (int j = 0; j < NJ; ++j) c += __popcll(__ballot(key[j] >= cand));
            if (c >= 256) ans = cand;
            if (c == 256) { exact = true; break; } }
        thr = ans;
        if (!exact) { int c = 0, cg = 0;
#pragma unroll
            for (int j = 0; j < NJ; ++j) { c += __popcll(__ballot(key[j] >= ans)); cg += __popcll(__ballot(key[j] > ans)); }
            if (c != 256) { ties = true; n_gt = cg; } }
    }
    int need = 256 - n_gt;
#pragma unroll
    for (int j = 0; j < NJ; ++j) {
        unsigned long long mk;
        if (!ties) mk = __ballot(key[j] >= thr);
        else { mk = __ballot(key[j] > thr); unsigned long long eq = __ballot(key[j] == thr);
            while (eq != 0ull && need > 0) { const unsigned long long low = eq & (~eq + 1ull); mk |= low; eq ^= low; --need; } }
        if (lane == 0) { mrow[2 * j] = (unsigned)mk; mrow[2 * j + 1] = (unsigned)(mk >> 32); }
    }
}

__device__ __forceinline__ void p2_dsa_unit(const Params& P, LAS unsigned char* lds, int b, int t0, int tid, int wave, int lane) {
    const bf16* QI = (const bf16*)(P.ws + WS_QI); const bf16* KI = (const bf16*)(P.ws + WS_KI); const float* WI = (const float*)(P.ws + WS_WI);
    const bf16* QA = (const bf16*)(P.ws + WS_QA); const bf16* KA = (const bf16*)(P.ws + WS_KA); const bf16* VA = (const bf16*)(P.ws + WS_VA); const bf16* GA = (const bf16*)(P.ws + WS_GA);
    const float* bias2 = (const float*)(P.ws + WS_BIAS); bf16* YM = (bf16*)(P.ws + WS_YM);
    LAS float* SC = (LAS float*)lds; LAS unsigned* MASK = (LAS unsigned*)(lds + AUX_OFF);
    const int nkeys = t0 + 16, ntile = (nkeys + 31) >> 5, nj = (nkeys + 63) >> 6;
    const int r = lane & 31, h = lane >> 5;
    {
        const int rb = wave & 3, par = wave >> 2;
        const int cq = (r >> 2) & 1, a = r >> 3, e = r & 3, q4 = 2 * cq + (a >> 1), hd = 4 * (a & 1) + e;
        const bf16* qp = QI + (size_t)(b * T + t0 + 4 * rb + q4) * 512 + hd * 64 + 8 * h;
        bf16x8 af[4];
#pragma unroll
        for (int s = 0; s < 4; ++s) af[s] = *(const bf16x8*)(qp + 16 * s);
        float w[16];
#pragma unroll
        for (int i = 0; i < 16; ++i) w[i] = WI[(size_t)(b * T + t0 + 4 * rb + 2 * h + (i >> 3)) * 8 + (i & 7)];
        for (int tl = par; tl < ntile; tl += 2) {
            const bf16* kp = KI + (size_t)(b * T + tl * 32 + r) * 64 + 8 * h;
            bf16x8 bk[4];
#pragma unroll
            for (int s = 0; s < 4; ++s) bk[s] = *(const bf16x8*)(kp + 16 * s);
            f32x16 acc = {};
#pragma unroll
            for (int s = 0; s < 4; ++s) acc = MFMA32(af[s], bk[s], acc);
            float s0 = 0.f, s1 = 0.f;
#pragma unroll
            for (int i = 0; i < 8; ++i) { s0 += w[i] * fmaxf(acc[i], 0.f); s1 += w[8 + i] * fmaxf(acc[8 + i], 0.f); }
            SC[(4 * rb + 2 * h) * 2048 + tl * 32 + r] = s0; SC[(4 * rb + 2 * h + 1) * 2048 + tl * 32 + r] = s1;
        }
    }
    __syncthreads();
#pragma unroll 1
    for (int qq = 0; qq < 2; ++qq) { const int q = 2 * wave + qq;
        if (nj <= 8) dsa_select_row<8>(SC + q * 2048, MASK + q * 64, t0 + q, nj, lane);
        else if (nj <= 16) dsa_select_row<16>(SC + q * 2048, MASK + q * 64, t0 + q, nj, lane);
        else if (nj <= 24) dsa_select_row<24>(SC + q * 2048, MASK + q * 64, t0 + q, nj, lane);
        else dsa_select_row<32>(SC + q * 2048, MASK + q * 64, t0 + q, nj, lane); }
    __syncthreads();
    {
        int lane_c = lane; asm volatile("" : "+v"(lane_c));
        const int r = lane_c & 31, h = lane_c >> 5, tid = wave * 64 + lane_c, lane = lane_c;
        const int khalf = wave >> 2, n = (wave >> 1) & 1, qh = wave & 1;
        const int q = 8 * qh + (r >> 2), g = r & 3, hd = 4 * n + g, tq = t0 + q; const size_t mq = (size_t)(b * T + t0 + q);
        bf16x8 bq[4];
#pragma unroll
        for (int s = 0; s < 4; ++s) bq[s] = *(const bf16x8*)(QA + mq * 512 + hd * 64 + 16 * s + 8 * h);
        f32x16 o0 = {}, o1 = {}; float m_run = -1.0e30f, l_run = 0.f;
        const int c0key = tid >> 4, c0part = tid & 15;
        const bf16* kg0 = KA + (size_t)(b * T + c0key) * 128 + c0part * 8; const bf16* vg0 = VA + (size_t)(b * T + c0key) * 128 + c0part * 8;
        v4u kreg[2], vreg[2];
#define DSA_LOAD(it) do { kreg[0] = *(const v4u*)(kg0 + (size_t)(it) * 64 * 128); kreg[1] = *(const v4u*)(kg0 + (size_t)((it) * 64 + 32) * 128); vreg[0] = *(const v4u*)(vg0 + (size_t)(it) * 64 * 128); vreg[1] = *(const v4u*)(vg0 + (size_t)((it) * 64 + 32) * 128); } while (0)
#define DSA_WRITE(buf) do { *(LAS v4u*)(lds + DSA_KST + (buf) * 64 * DSA_KROW + c0key * DSA_KROW + c0part * 16) = kreg[0]; *(LAS v4u*)(lds + DSA_KST + (buf) * 64 * DSA_KROW + (c0key + 32) * DSA_KROW + c0part * 16) = kreg[1]; \
        *(LAS v4u*)(lds + DSA_VST + (buf) * 64 * DSA_VROW + c0key * DSA_VROW + c0part * 16) = vreg[0]; *(LAS v4u*)(lds + DSA_VST + (buf) * 64 * DSA_VROW + (c0key + 32) * DSA_VROW + c0part * 16) = vreg[1]; } while (0)
        DSA_LOAD(0); DSA_WRITE(0);
        __syncthreads();
        const int i16 = lane & 15, tq4 = i16 >> 2, tp4 = i16 & 3;
        for (int it = 0; it < nj; ++it) {
            const int buf = it & 1;
            if (it + 1 < nj) DSA_LOAD(it + 1);
            const int tl = 2 * it + khalf;
            if (tl < ntile) {
                LAS unsigned char* kb = lds + DSA_KST + buf * 64 * DSA_KROW + (khalf * 32 + r) * DSA_KROW + n * 128 + 16 * h;
                f32x16 acc = {};
#pragma unroll
                for (int s = 0; s < 4; ++s) acc = MFMA32(*(LAS bf16x8*)(kb + 32 * s), bq[s], acc);
                const unsigned mw = MASK[q * 64 + tl];
                float lgt[16]; float mx = -1.0e30f;
                if (tl * 32 + 158 <= t0) { const float bc = bias2[127 * 8 + hd];
#pragma unroll
                    for (int i = 0; i < 16; ++i) { lgt[i] = acc[i] + bc; if ((mw >> crow(i, h)) & 1u) mx = fmaxf(mx, lgt[i]); } }
                else {
#pragma unroll
                    for (int i = 0; i < 16; ++i) { int dist = tq - (tl * 32 + crow(i, h)); dist = dist < 0 ? 0 : (dist > 127 ? 127 : dist); lgt[i] = acc[i] + bias2[dist * 8 + hd]; if ((mw >> crow(i, h)) & 1u) mx = fmaxf(mx, lgt[i]); } }
                mx = fmaxf(mx, __shfl_xor(mx, 32));
                const float m_new = fmaxf(m_run, mx), alpha = __builtin_amdgcn_exp2f(m_run - m_new); m_run = m_new;
                float psum = 0.f;
#pragma unroll
                for (int i = 0; i < 16; ++i) { const float p = ((mw >> crow(i, h)) & 1u) ? __builtin_amdgcn_exp2f(lgt[i] - m_new) : 0.f; lgt[i] = p; psum += p; }
                l_run = l_run * alpha + psum;
#pragma unroll
                for (int i = 0; i < 16; ++i) { o0[i] *= alpha; o1[i] *= alpha; }
                bf16x8 pb[2];
                pb[0] = pack8((f32x4){lgt[0], lgt[1], lgt[2], lgt[3]}, (f32x4){lgt[4], lgt[5], lgt[6], lgt[7]});
                pb[1] = pack8((f32x4){lgt[8], lgt[9], lgt[10], lgt[11]}, (f32x4){lgt[12], lgt[13], lgt[14], lgt[15]});
                LAS unsigned char* vb = lds + DSA_VST + buf * 64 * DSA_VROW + (khalf * 32 + 4 * h + tq4) * DSA_VROW + (n * 64 + 16 * (r >> 4) + 4 * tp4) * 2;
#pragma unroll
                for (int s = 0; s < 2; ++s) {
                    const s16x4 lo0 = tr_read(vb + (16 * s) * DSA_VROW), hi0 = tr_read(vb + (16 * s + 8) * DSA_VROW);
                    const s16x4 lo1 = tr_read(vb + (16 * s) * DSA_VROW + 64), hi1 = tr_read(vb + (16 * s + 8) * DSA_VROW + 64);
                    o0 = MFMA32(__builtin_shufflevector(lo0, hi0, 0, 1, 2, 3, 4, 5, 6, 7), pb[s], o0);
                    o1 = MFMA32(__builtin_shufflevector(lo1, hi1, 0, 1, 2, 3, 4, 5, 6, 7), pb[s], o1);
                }
            }
            if (it + 1 < nj) DSA_WRITE(buf ^ 1);
            __syncthreads();
        }
#undef DSA_LOAD
#undef DSA_WRITE
        float l_tot = l_run + __shfl_xor(l_run, 32);
        LAS float* xw = (LAS float*)(lds + DSA_XCH) + ((wave & 3) * 64 + lane) * 34;
        if (khalf == 1) { xw[0] = m_run; xw[1] = l_tot;
#pragma unroll
            for (int i = 0; i < 16; ++i) { xw[2 + i] = o0[i]; xw[18 + i] = o1[i]; } }
        __syncthreads();
        if (khalf == 0) {
            int h_o = h; asm volatile("" : "+v"(h_o));
            const int h = h_o;
            const float m1 = xw[0], l1 = xw[1], m = fmaxf(m_run, m1), a0 = __builtin_amdgcn_exp2f(m_run - m), a1 = __builtin_amdgcn_exp2f(m1 - m);
            const float inv = 1.0f / (l_tot * a0 + l1 * a1);
#pragma unroll
            for (int dblk = 0; dblk < 2; ++dblk)
#pragma unroll
                for (int a4 = 0; a4 < 4; ++a4) { const int d = dblk * 32 + 8 * a4 + 4 * h; float ov[4];
#pragma unroll
                    for (int e = 0; e < 4; ++e) { const int i = 4 * a4 + e; const float mine = dblk ? o1[i] : o0[i]; ov[e] = (mine * a0 + xw[2 + dblk * 16 + i] * a1) * inv; }
                    const u32x2v gw = *(const u32x2v*)(GA + mq * 512 + hd * 64 + d);
                    u32x2v ow; ow.x = cvtpk(ov[0] * bf_lo(gw.x), ov[1] * bf_hi(gw.x)); ow.y = cvtpk(ov[2] * bf_lo(gw.y), ov[3] * bf_hi(gw.y));
                    *(u32x2v*)(YM + mq * DM + hd * 64 + d) = ow; }
        }
    }
    __syncthreads();
}

constexpr int RT_ROW = 144, RT_TILE = 128 * RT_ROW, RT_BUF = 3 * RT_TILE, RT_ST = 2 * RT_BUF, RT_UP = RT_ST + 64 * RT_ROW, RT_NS = RT_UP + 16384, RT_END = RT_NS + 2048;
static_assert(RT_END <= LDSCTL_OFF, "retention LDS map");
__device__ __forceinline__ void p2_ret_item(const Params& P, LAS unsigned char* lds, int b, int h, int tid, int wave, int lane) {
    const bf16* QB = (const bf16*)(P.ws + WS_QB); const bf16* KB = (const bf16*)(P.ws + WS_KB); const bf16* VB = (const bf16*)(P.ws + WS_VB); const bf16* GB = (const bf16*)(P.ws + WS_GB); bf16* YM = (bf16*)(P.ws + WS_YM);
    const float l2g = pg8::log2g_of(h), g1 = __builtin_amdgcn_exp2f(l2g), g127 = __builtin_amdgcn_exp2f(127.0f * l2g), g128 = __builtin_amdgcn_exp2f(128.0f * l2g);
    const int r = lane & 31, hh = lane >> 5, i16 = lane & 15, tq4 = i16 >> 2, tp4 = i16 & 3;
    const int tb = wave >> 1, dvb = wave & 1, dkb = (wave >> 1) & 1, th = wave >> 2;
    for (int i = tid; i < 64 * RT_ROW / 4; i += 512) ((LAS unsigned*)(lds + RT_ST))[i] = 0u;
    f32x16 sm = {};
    const int lrow = tid >> 3, lpart = tid & 7;
    const size_t gofs = (size_t)(b * T + lrow) * 512 + h * 64 + lpart * 8;
    v4u lreg[6];
#define RT_LOAD(c) do { const size_t o_ = gofs + (size_t)(c) * 128 * 512; lreg[0] = *(const v4u*)(QB + o_); lreg[1] = *(const v4u*)(QB + o_ + 64 * 512); lreg[2] = *(const v4u*)(KB + o_); lreg[3] = *(const v4u*)(KB + o_ + 64 * 512); \
        lreg[4] = *(const v4u*)(VB + o_); lreg[5] = *(const v4u*)(VB + o_ + 64 * 512); } while (0)
#define RT_WRITE(buf) do { LAS unsigned char* d_ = lds + (buf) * RT_BUF + lrow * RT_ROW + lpart * 16; \
        *(LAS v4u*)(d_) = lreg[0]; *(LAS v4u*)(d_ + 64 * RT_ROW) = lreg[1]; *(LAS v4u*)(d_ + RT_TILE) = lreg[2]; *(LAS v4u*)(d_ + RT_TILE + 64 * RT_ROW) = lreg[3]; \
        *(LAS v4u*)(d_ + 2 * RT_TILE) = lreg[4]; *(LAS v4u*)(d_ + 2 * RT_TILE + 64 * RT_ROW) = lreg[5]; } while (0)
    RT_LOAD(0); RT_WRITE(0);
    __syncthreads();
    LAS float* NS = (LAS float*)(lds + RT_NS); LAS float* UP = (LAS float*)(lds + RT_UP);
    for (int c = 0; c < 16; ++c) {
        const int cur = c & 1; LAS unsigned char* Qt = lds + cur * RT_BUF; LAS unsigned char* Kt = Qt + RT_TILE; LAS unsigned char* Vt = Kt + RT_TILE;
        if (c + 1 < 16) RT_LOAD(c + 1);
        bf16x8 qf[4];
#pragma unroll
        for (int s = 0; s < 4; ++s) qf[s] = *(LAS bf16x8*)(Qt + (tb * 32 + r) * RT_ROW + (16 * s + 8 * hh) * 2);
        f32x16 o = {};
#pragma unroll
        for (int s = 0; s < 4; ++s) o = MFMA32(*(LAS bf16x8*)(lds + RT_ST + (dvb * 32 + r) * RT_ROW + (16 * s + 8 * hh) * 2), qf[s], o);
#pragma unroll
        for (int i = 0; i < 16; ++i) o[i] *= g1;
        for (int sb = 0; sb <= tb; ++sb) {
            f32x16 p = {};
#pragma unroll
            for (int s = 0; s < 4; ++s) p = MFMA32(*(LAS bf16x8*)(Kt + (sb * 32 + r) * RT_ROW + (16 * s + 8 * hh) * 2), qf[s], p);
            if (sb == tb) {
#pragma unroll
                for (int i = 0; i < 16; ++i) if (crow(i, hh) > r) p[i] = 0.f; }
            bf16x8 pb[2];
            pb[0] = pack8((f32x4){p[0], p[1], p[2], p[3]}, (f32x4){p[4], p[5], p[6], p[7]});
            pb[1] = pack8((f32x4){p[8], p[9], p[10], p[11]}, (f32x4){p[12], p[13], p[14], p[15]});
            LAS unsigned char* vb = Vt + (sb * 32 + 4 * hh + tq4) * RT_ROW + (dvb * 32 + 16 * (r >> 4) + 4 * tp4) * 2;
#pragma unroll
            for (int s2 = 0; s2 < 2; ++s2) { const s16x4 lo = tr_read(vb + (16 * s2) * RT_ROW), hi = tr_read(vb + (16 * s2 + 8) * RT_ROW);
                o = MFMA32(__builtin_shufflevector(lo, hi, 0, 1, 2, 3, 4, 5, 6, 7), pb[s2], o); }
        }
        f32x16 u = {};
        { LAS unsigned char* ka = Kt + (th * 64 + 8 * hh + tq4) * RT_ROW + (dkb * 32 + 16 * (r >> 4) + 4 * tp4) * 2; LAS unsigned char* va = Vt + (th * 64 + 8 * hh + tq4) * RT_ROW + (dvb * 32 + 16 * (r >> 4) + 4 * tp4) * 2;
#pragma unroll
          for (int s = 0; s < 4; ++s) { const s16x4 klo = tr_read(ka + (16 * s) * RT_ROW), khi = tr_read(ka + (16 * s + 4) * RT_ROW), vlo = tr_read(va + (16 * s) * RT_ROW), vhi = tr_read(va + (16 * s + 4) * RT_ROW);
              u = MFMA32(__builtin_shufflevector(klo, khi, 0, 1, 2, 3, 4, 5, 6, 7), __builtin_shufflevector(vlo, vhi, 0, 1, 2, 3, 4, 5, 6, 7), u); } }
        if (wave >= 4) {
#pragma unroll
            for (int i = 0; i < 16; ++i) UP[((wave - 4) * 64 + lane) * 16 + i] = u[i]; }
        float s1 = 0.f, s2 = 0.f;
#pragma unroll
        for (int i = 0; i < 16; ++i) { s1 += o[i]; s2 += o[i] * o[i]; }
        s1 += __shfl_xor(s1, 32); s2 += __shfl_xor(s2, 32);
        if (hh == 0) { NS[((tb * 2 + dvb) * 32 + r) * 2] = s1; NS[((tb * 2 + dvb) * 32 + r) * 2 + 1] = s2; }
        __syncthreads();
        if (wave < 4) {
#pragma unroll
            for (int i = 0; i < 16; ++i) sm[i] = g128 * sm[i] + g127 * (u[i] + UP[(wave * 64 + lane) * 16 + i]);
#pragma unroll
            for (int a4 = 0; a4 < 4; ++a4) { u32x2v w2; w2.x = cvtpk(sm[4 * a4], sm[4 * a4 + 1]); w2.y = cvtpk(sm[4 * a4 + 2], sm[4 * a4 + 3]);
                *(LAS u32x2v*)(lds + RT_ST + (dvb * 32 + r) * RT_ROW + (dkb * 32 + 8 * a4 + 4 * hh) * 2) = w2; }
        }
        { const float t1 = s1 + NS[((tb * 2 + (dvb ^ 1)) * 32 + r) * 2], t2 = s2 + NS[((tb * 2 + (dvb ^ 1)) * 32 + r) * 2 + 1];
          const float mu = t1 * (1.0f / 64.0f), var = t2 * (1.0f / 64.0f) - mu * mu, rs = 1.0f / sqrtf(fmaxf(var, 0.f) + EPS);
          const size_t m = (size_t)(b * T + c * 128 + tb * 32 + r);
#pragma unroll
          for (int a4 = 0; a4 < 4; ++a4) { const int dv = dvb * 32 + 8 * a4 + 4 * hh; const u32x2v gw = *(const u32x2v*)(GB + m * 512 + h * 64 + dv);
              u32x2v ow; ow.x = cvtpk((o[4 * a4] - mu) * rs * bf_lo(gw.x), (o[4 * a4 + 1] - mu) * rs * bf_hi(gw.x)); ow.y = cvtpk((o[4 * a4 + 2] - mu) * rs * bf_lo(gw.y), (o[4 * a4 + 3] - mu) * rs * bf_hi(gw.y));
              *(u32x2v*)(YM + m * DM + 512 + h * 64 + dv) = ow; } }
        if (c + 1 < 16) RT_WRITE(cur ^ 1);
        __syncthreads();
    }
#undef RT_LOAD
#undef RT_WRITE
    if (wave < 4) {
        int r2 = r, h2 = hh; asm volatile("" : "+v"(r2), "+v"(h2));
        float* ob = P.out + O_RSP + (size_t)(b * 8 + h) * 4096 + dvb * 32 + r2;
#pragma unroll
        for (int i = 0; i < 16; ++i) { const int p = dkb * 32 + crow(i, h2), d = (p & 1) ? 32 + (p >> 1) : (p >> 1); ob[d * 64] = sm[i]; }
    }
    __syncthreads();
}

#ifndef FAST_P3
#define FAST_P3 0
#endif
#ifndef FAST_DSA
#define FAST_DSA 1
#endif
#ifndef FAST_RET
#define FAST_RET 1
#endif
constexpr size_t WS_YF = 292 * MiB, WS_END2 = 356 * MiB;
__global__ void __launch_bounds__(NWAVES * 64, 2) hymba_fwd(Params P) {
    extern __shared__ __attribute__((aligned(16))) unsigned char lds_raw[];
    LAS unsigned char* lds = (LAS unsigned char*)lds_raw;
    const int wave = __builtin_amdgcn_readfirstlane(threadIdx.x >> 6);
#define LANE_TID const int lane = lane_id(), tid = wave * 64 + lane
    const int G = gridDim.x, bx = blockIdx.x; const int vcu = (G % 8 == 0) ? (bx % 8) * (G / 8) + bx / 8 : bx;
    gu32* ctl = (gu32*)(P.ws + WS_CTL);
    volatile LAS unsigned* MISC = (volatile LAS unsigned*)(lds + LDSCTL_OFF);
    { LANE_TID; for (int u = tid; u < (LDS_BYTES - LDSCTL_OFF) / 4; u += NWAVES * 64) ((LAS unsigned*)(lds + LDSCTL_OFF))[u] = 0u; }
    __syncthreads();
    XcdBarrier bar = xcd_barrier_post((unsigned*)(ctl + CW_BAR), MISC + 8, wave == 0 && lane_id() == 0);
#define GRID_BAR() xcd_barrier(bar, wave == 0 && lane_id() == 0)
    const int lo = P.ph_lo, hi = P.ph_hi;
#define IN(k) (lo <= (k) && (k) < hi)
#define BOTH(k) (IN(k) && IN((k) + 1))

    if (IN(0)) { LANE_TID; p0_prologue(P, lds, vcu, G, wave, lane, tid); if (BOTH(0)) GRID_BAR(); }

    if (IN(1)) {
        if (vcu < SB * 8) p1_sample_index(P, vcu, wave, lane_id());
        {
            pg8::Gemm g{(const pg8::bf16_t*)(P.ws + WS_XB), (const pg8::bf16_t*)(P.ws + WS_WIN), M, NPAD, DM}; pg8::StaticOrder S; S.init(M, NPAD, G, bx);
            pg8::EpiInProj E{P.ws, P.out};
            pg8::gemm_phase<pg8::EpiInProj, pg8::StaticOrder, true, true, DM>(lds, g, S, E, wave, lane_id());
        }
        {
            pg8::Gemm g{(const pg8::bf16_t*)(P.ws + WS_PB), (const pg8::bf16_t*)(P.ws + WS_WUP), M, DM, DPLE}; pg8::StaticOrder S; S.init(M, DM, G, bx);
            pg8::EpiPlain E{(pg8::bf16_t*)(P.ws + WS_PLE), DM};
            pg8::gemm_phase<pg8::EpiPlain, pg8::StaticOrder, true, true, DPLE>(lds, g, S, E, wave, lane_id());
        }
        if (BOTH(1)) GRID_BAR();
    }

    if (IN(2)) {
        LANE_TID; __syncthreads();
        for (int u = vcu; u < SB * SQ; u += G) p2_sample_attn(P, lds, u, tid, wave, lane);
        for (int u = vcu; u < SB * 8; u += G) p2_sample_ret(P, lds, u, tid, wave, lane);
#if !FAST_RET
        for (int u = vcu; u < NB * 8; u += G) np2_ret_state(P, u, tid);
#endif
#if FAST_DSA
        for (;;) {
            if (tid == 0) MISC[16] = __hip_atomic_fetch_add((unsigned*)(P.ws + WS_CTL) + CW_QUEUE, 1u, __ATOMIC_RELAXED, __HIP_MEMORY_SCOPE_AGENT);
            __syncthreads(); const unsigned k = MISC[16]; __syncthreads();
            if (k >= (unsigned)(NB * 128 + FAST_RET * NB * 8)) break;
#if FAST_RET
            if (k < (unsigned)(NB * 8)) { p2_ret_item(P, lds, (int)(k >> 3), (int)(k & 7u), tid, wave, lane); continue; }
            const unsigned kk = k - NB * 8;
#else
            const unsigned kk = k;
#endif
            p2_dsa_unit(P, lds, (int)(kk & 7u), (127 - (int)(kk >> 3)) * 16, tid, wave, lane);
        }
#else
        for (int u = vcu; u < M; u += G) np2_dsa_query(P, lds, u, tid, wave, lane);
#endif
#if !FAST_RET
        for (int u = vcu; u < NB * 8 * 256; u += G) np2_ret_block(P, lds, u, tid, wave, lane);
#endif
        if (BOTH(2)) GRID_BAR();
    }

    if (IN(3)) {
        __syncthreads();
        { LANE_TID; for (int u = vcu; u < MS; u += G) p3_sample_merge(P, lds, u, tid, wave, lane); }
        __syncthreads();
        {
            pg8::Gemm g{(const pg8::bf16_t*)(P.ws + WS_YM), (const pg8::bf16_t*)(P.ws + WS_WOUT), M, DM, DM}; pg8::StaticOrder S; S.init(M, DM, G, bx);
            pg8::EpiF32 E{(float*)(P.ws + WS_YF), DM};
            pg8::gemm_phase<pg8::EpiF32, pg8::StaticOrder, true, true, DM>(lds, g, S, E, wave, lane_id());
        }
        if (BOTH(3)) GRID_BAR();
    }
    if (IN(4)) {
        LANE_TID;
        const int gw = vcu * NWAVES + wave, NGW = G * NWAVES; const float* yf = (const float*)(P.ws + WS_YF); bf16* x1b = (bf16*)(P.ws + WS_X1B);
        for (int m = gw; m < M; m += NGW) {
            f32x4 v[4]; float s = 0.f;
#pragma unroll
            for (int j = 0; j < 4; ++j) { v[j] = *((const f32x4*)(yf + (size_t)m * DM) + lane + 64 * j); s += (v[j].x * v[j].x + v[j].y * v[j].y) + (v[j].z * v[j].z + v[j].w * v[j].w); }
            s = wave_sum(s); const float rs = 1.0f / sqrtf(s * (1.0f / DM) + EPS);
#pragma unroll
            for (int j = 0; j < 4; ++j) { const f32x4 xv = *((const f32x4*)(P.x_p + (size_t)m * DM) + lane + 64 * j), gp = *((const f32x4*)P.g_post + lane + 64 * j); const f32x4 o = xv + v[j] * rs * gp;
                *((f32x4*)(P.out + O_YP + (size_t)m * DM) + lane + 64 * j) = o; u32x2v w; w.x = cvtpk(o.x, o.y); w.y = cvtpk(o.z, o.w); *((u32x2v*)(x1b + (size_t)m * DM) + lane + 64 * j) = w; }
        }
        if (BOTH(4)) GRID_BAR();
    }
    if (IN(5)) {
        pg8::Gemm g{(const pg8::bf16_t*)(P.ws + WS_X1B), (const pg8::bf16_t*)(P.ws + WS_WGATE), M, DM, DM}; pg8::StaticOrder S; S.init(M, DM, G, bx);
        pg8::EpiGate E{P.out + O_YP, (const pg8::bf16_t*)(P.ws + WS_PLE), DM};
        pg8::gemm_phase<pg8::EpiGate, pg8::StaticOrder, true, true, DM>(lds, g, S, E, wave, lane_id());
    }
#undef IN
#undef BOTH
}

#ifndef MK_N_LAUNCHES
#define MK_N_LAUNCHES 1
#endif
constexpr int N_PHASES = 6;
extern "C" void kernel_launch(void* const* d_in, const int* in_sizes, int n_in, void* d_out, int out_size, void* d_ws, size_t ws_size, hipStream_t stream) {
    static int grid = 0;
    if (grid == 0) {
        if (n_in != 16 || (size_t)out_size != O_END || ws_size < WS_END2) { fprintf(stderr, "kernel_launch: unexpected shapes (n_in %d out %d ws %zu); nothing launched\n", n_in, out_size, ws_size); grid = -1; return; }
        int dev = 0, cus = 0;
        if (hipGetDevice(&dev) != hipSuccess || hipDeviceGetAttribute(&cus, hipDeviceAttributeMultiprocessorCount, dev) != hipSuccess) { grid = -1; return; }
        if (hipFuncSetAttribute((const void*)hymba_fwd, hipFuncAttributeMaxDynamicSharedMemorySize, LDS_BYTES) != hipSuccess) { fprintf(stderr, "kernel_launch: hipFuncSetAttribute failed\n"); grid = -1; return; }
        (void)hipGetLastError();
        grid = cus;
        if (grid != 256) fprintf(stderr, "kernel_launch: %d CUs (built for 256)\n", grid);
    }
    if (grid < 0) return;
    if (hipMemsetAsync((char*)d_ws + WS_CTL, 0, CTL_ZERO_BYTES, stream) != hipSuccess) return;
    Params a{};
    a.x_p = (const float*)d_in[0]; a.x_s = (const float*)d_in[1]; a.cache_k = (const float*)d_in[2]; a.cache_v = (const float*)d_in[3]; a.cache_kidx = (const float*)d_in[4];
    a.state_ret = (const float*)d_in[5]; a.page_table = (const int*)d_in[6]; a.p_p = (const float*)d_in[7]; a.p_s = (const float*)d_in[8]; a.rel_bias = (const float*)d_in[9];
    a.w_in = (const float*)d_in[10]; a.w_out = (const float*)d_in[11]; a.g_pre = (const float*)d_in[12]; a.g_post = (const float*)d_in[13]; a.w_up = (const float*)d_in[14]; a.w_gate = (const float*)d_in[15];
    a.out = (float*)d_out; a.ws = (unsigned char*)d_ws;
    if (MK_N_LAUNCHES == 1) { a.ph_lo = 0; a.ph_hi = N_PHASES; hipLaunchKernelGGL(hymba_fwd, dim3(grid), dim3(NWAVES * 64), LDS_BYTES, stream, a); }
    else for (int p = 0; p < N_PHASES; ++p) { a.ph_lo = p; a.ph_hi = p + 1; hipLaunchKernelGGL(hymba_fwd, dim3(grid), dim3(NWAVES * 64), LDS_BYTES, stream, a); }
}
```
